# Optimizing an MI355X kernel written in HIP

```python
import jax, jax.numpy as jnp
from jax import lax
import numpy as np

D_MODEL = 2048
BATCH = 4
SEQ = 4096
DEPTH = 2
DEC_BATCH = 16
DEC_SEQ = 64
PAST_LEN = 1024

CHUNK = 64
N_A_LAYERS = DEPTH // 2
N_B_LAYERS = DEPTH - N_A_LAYERS
D_FF = ((8 * D_MODEL // 3 + 255) // 256) * 256
D_RNN = D_MODEL * 5 // 4
RNN_BLOCK = 256
N_RNN_HEADS = D_RNN // RNN_BLOCK
CONV_W = 4
LRU_C = 8.0
HEAD_DIM = 128
N_HEADS = D_MODEL // HEAD_DIM
ATTN_SCALE = HEAD_DIM ** -0.5
Q_BLOCK = 128
RMS_EPS = 1e-6
FORGET_BIAS_INIT = 3.0

kernel_name = 'hybrid_rglru_fox_yoco_step'


def rms_norm(x, g):
    xf = x.astype(jnp.float32)
    y = xf * lax.rsqrt(jnp.mean(xf * xf, axis=-1, keepdims=True) + RMS_EPS)
    return (y * g.astype(jnp.float32)).astype(x.dtype)


def swiglu_ffn(x, g, w_in, w_out):
    gate, up = jnp.split(rms_norm(x, g) @ w_in, 2, axis=-1)
    return (jax.nn.silu(gate) * up) @ w_out


def causal_conv(u, buf, w, b):
    t = u.shape[1]
    up = jnp.concatenate([buf.astype(u.dtype), u], axis=1)
    out = b
    for k in range(CONV_W):
        out = out + up[:, k:k + t] * w[k]
    return out, up[:, t:]


def rg_lru(x, h0, gate_w, gate_b, lam):
    b, t, _ = x.shape
    xf = x.astype(jnp.float32)
    xb = xf.reshape(b, t, N_RNN_HEADS, RNN_BLOCK)
    gates = jnp.einsum('bthi,ghij->gbthj', xb, gate_w.astype(jnp.float32)).reshape(2, b, t, D_RNN)
    gates = gates + gate_b.astype(jnp.float32)[:, None, None, :]
    r = jax.nn.sigmoid(gates[0])
    i = jax.nn.sigmoid(gates[1])
    log_a = -LRU_C * r * jax.nn.softplus(-lam.astype(jnp.float32))
    a = jnp.exp(log_a)
    inp = jnp.sqrt(-jnp.expm1(2.0 * log_a)) * (i * xf)
    inp = inp.at[:, 0].add(a[:, 0] * h0.astype(jnp.float32))

    def combine(c1, c2):
        a1, b1 = c1
        a2, b2 = c2
        return a1 * a2, a2 * b1 + b2

    _, h = lax.associative_scan(combine, (a, inp), axis=1)
    return h.astype(x.dtype), h[:, -1].astype(x.dtype)


def rglru_layer(x, conv_buf, h0, norm, w_in, conv_w, conv_b, gate_w, gate_b, lam, w_out):
    xn = rms_norm(x, norm)
    gate, u = jnp.split(xn @ w_in, 2, axis=-1)
    u, new_buf = causal_conv(u, conv_buf, conv_w, conv_b)
    h, h_last = rg_lru(u, h0, gate_w, gate_b, lam)
    return (h * jax.nn.gelu(gate)) @ w_out, new_buf, h_last


def shared_kv(x, kv_norm, w_kv, w_f, b_f):
    b, t = x.shape[:2]
    xn = rms_norm(x, kv_norm)
    k, v = jnp.split(xn @ w_kv, 2, axis=-1)
    logf = jax.nn.log_sigmoid((xn @ w_f).astype(jnp.float32) + b_f.astype(jnp.float32))
    return (k.reshape(b, t, N_HEADS, HEAD_DIM), v.reshape(b, t, N_HEADS, HEAD_DIM), logf)


def fox_attend(q, k, v, cq, ck, q_pos, k_pos):
    s = jnp.einsum('bqhd,bkhd->bhqk', q, k).astype(jnp.float32) * ATTN_SCALE
    s = s + jnp.swapaxes(cq, 1, 2)[:, :, :, None] - jnp.swapaxes(ck, 1, 2)[:, :, None, :]
    s = jnp.where(k_pos[None, None, None, :] <= q_pos[None, None, :, None], s, -jnp.inf)
    p = jax.nn.softmax(s, axis=-1)
    return jnp.einsum('bhqk,bkhd->bqhd', p.astype(v.dtype), v)


def fox_prompt(q, k, v, logf):
    b, s, h, d = q.shape
    c = jnp.cumsum(logf, axis=1)
    nb = s // Q_BLOCK
    qb = jnp.swapaxes(q.reshape(b, nb, Q_BLOCK, h, d), 0, 1)
    cqb = jnp.swapaxes(c.reshape(b, nb, Q_BLOCK, h), 0, 1)
    k_pos = jnp.arange(s)

    def one_block(args):
        qi, cqi, bi = args
        q_pos = bi * Q_BLOCK + jnp.arange(Q_BLOCK)
        return fox_attend(qi, k, v, cqi, c, q_pos, k_pos)

    o = lax.map(one_block, (qb, cqb, jnp.arange(nb)))
    return jnp.swapaxes(o, 0, 1).reshape(b, s, h, d)


def fox_sample(q, k_new, v_new, logf_new, cache_k, cache_v, cache_logf):
    past = cache_k.shape[1]
    t = q.shape[1]
    k = jnp.concatenate([cache_k, k_new], axis=1)
    v = jnp.concatenate([cache_v, v_new], axis=1)
    c = jnp.cumsum(jnp.concatenate([cache_logf.astype(jnp.float32), logf_new], axis=1), axis=1)
    return fox_attend(q, k, v, c[:, past:], c, past + jnp.arange(t), jnp.arange(past + t))


def fox_query(x, norm, w_qg):
    b, t = x.shape[:2]
    q, g = jnp.split(rms_norm(x, norm) @ w_qg, 2, axis=-1)
    return q.reshape(b, t, N_HEADS, HEAD_DIM), g


def fox_output(o, g, w_o):
    b, t = o.shape[:2]
    return (o.reshape(b, t, N_HEADS * HEAD_DIM) * jax.nn.sigmoid(g)) @ w_o


def setup_inputs(seed: int = 0) -> dict:
    key = jax.random.key(seed)
    ks = jax.random.split(key, 28)
    f32 = jnp.float32

    def nrm(k, shape, scale=1.0):
        return jax.random.normal(k, shape, f32) * scale

    a0 = jax.random.uniform(ks[14], (N_A_LAYERS, D_RNN), f32, 0.9, 0.999)
    p = a0 ** (1.0 / LRU_C)
    return {
        'x_prompt': nrm(ks[0], (BATCH, SEQ, D_MODEL)),
        'x_sample': nrm(ks[1], (DEC_BATCH, DEC_SEQ, D_MODEL)),
        'state_conv': nrm(ks[2], (N_A_LAYERS, DEC_BATCH, CONV_W - 1, D_RNN)),
        'state_h': nrm(ks[3], (N_A_LAYERS, DEC_BATCH, D_RNN), 0.5),
        'cache_k': nrm(ks[4], (DEC_BATCH, PAST_LEN, N_HEADS, HEAD_DIM)),
        'cache_v': nrm(ks[5], (DEC_BATCH, PAST_LEN, N_HEADS, HEAD_DIM)),
        'cache_logf': jax.nn.log_sigmoid(FORGET_BIAS_INIT + nrm(ks[6], (DEC_BATCH, PAST_LEN, N_HEADS), 0.5)),
        'ffn_norm': 1.0 + nrm(ks[7], (DEPTH, 2, D_MODEL), 0.05),
        'ffn_w_in': nrm(ks[8], (DEPTH, 2, D_MODEL, 2 * D_FF), D_MODEL ** -0.5),
        'ffn_w_out': nrm(ks[9], (DEPTH, 2, D_FF, D_MODEL), D_FF ** -0.5),
        'a_norm': 1.0 + nrm(ks[10], (N_A_LAYERS, D_MODEL), 0.05),
        'a_w_in': nrm(ks[11], (N_A_LAYERS, D_MODEL, 2 * D_RNN), D_MODEL ** -0.5),
        'a_conv_w': nrm(ks[12], (N_A_LAYERS, CONV_W, D_RNN), CONV_W ** -0.5),
        'a_conv_b': nrm(ks[13], (N_A_LAYERS, D_RNN), 0.01),
        'a_gate_w': nrm(ks[15], (N_A_LAYERS, 2, N_RNN_HEADS, RNN_BLOCK, RNN_BLOCK), RNN_BLOCK ** -0.5),
        'a_gate_b': nrm(ks[16], (N_A_LAYERS, 2, D_RNN), 0.01),
        'a_lambda': jnp.log(p) - jnp.log1p(-p),
        'a_w_out': nrm(ks[17], (N_A_LAYERS, D_RNN, D_MODEL), D_RNN ** -0.5),
        'kv_norm': 1.0 + nrm(ks[18], (D_MODEL,), 0.05),
        'w_kv': nrm(ks[19], (D_MODEL, 2 * D_MODEL), D_MODEL ** -0.5),
        'w_f': nrm(ks[20], (D_MODEL, N_HEADS), 0.5 * D_MODEL ** -0.5),
        'b_f': FORGET_BIAS_INIT + nrm(ks[21], (N_HEADS,), 0.1),
        'b_norm': 1.0 + nrm(ks[22], (N_B_LAYERS, D_MODEL), 0.05),
        'b_w_qg': nrm(ks[23], (N_B_LAYERS, D_MODEL, 2 * D_MODEL), D_MODEL ** -0.5),
        'b_w_o': nrm(ks[24], (N_B_LAYERS, D_MODEL, D_MODEL), D_MODEL ** -0.5),
        'final_norm': 1.0 + nrm(ks[25], (D_MODEL,), 0.05),
    }


def reference(x_prompt, x_sample, state_conv, state_h, cache_k, cache_v, cache_logf,
              ffn_norm, ffn_w_in, ffn_w_out, a_norm, a_w_in, a_conv_w, a_conv_b, a_gate_w,
              a_gate_b, a_lambda, a_w_out, kv_norm, w_kv, w_f, b_f, b_norm, b_w_qg, b_w_o,
              final_norm):
    xp, xs = x_prompt, x_sample
    bp = x_prompt.shape[0]
    conv_p, h_p, conv_s, h_s = [], [], [], []
    for l in range(DEPTH):
        xp = xp + 0.5 * swiglu_ffn(xp, ffn_norm[l, 0], ffn_w_in[l, 0], ffn_w_out[l, 0])
        xs = xs + 0.5 * swiglu_ffn(xs, ffn_norm[l, 0], ffn_w_in[l, 0], ffn_w_out[l, 0])
        if l < N_A_LAYERS:
            buf0 = jnp.zeros((bp, CONV_W - 1, D_RNN), xp.dtype)
            h0 = jnp.zeros((bp, D_RNN), xp.dtype)
            yp, cp, hp = rglru_layer(xp, buf0, h0, a_norm[l], a_w_in[l], a_conv_w[l], a_conv_b[l],
                                     a_gate_w[l], a_gate_b[l], a_lambda[l], a_w_out[l])
            ys, cs, hs = rglru_layer(xs, state_conv[l], state_h[l], a_norm[l], a_w_in[l], a_conv_w[l],
                                     a_conv_b[l], a_gate_w[l], a_gate_b[l], a_lambda[l], a_w_out[l])
            conv_p.append(cp)
            h_p.append(hp)
            conv_s.append(cs)
            h_s.append(hs)
        else:
            j = l - N_A_LAYERS
            qp, gp = fox_query(xp, b_norm[j], b_w_qg[j])
            yp = fox_output(fox_prompt(qp, kp, vp, fp), gp, b_w_o[j])
            qs, gs = fox_query(xs, b_norm[j], b_w_qg[j])
            ys = fox_output(fox_sample(qs, ks_, vs_, fs_, cache_k, cache_v, cache_logf), gs, b_w_o[j])
        xp = xp + yp
        xs = xs + ys
        xp = xp + 0.5 * swiglu_ffn(xp, ffn_norm[l, 1], ffn_w_in[l, 1], ffn_w_out[l, 1])
        xs = xs + 0.5 * swiglu_ffn(xs, ffn_norm[l, 1], ffn_w_in[l, 1], ffn_w_out[l, 1])
        if l == N_A_LAYERS - 1:
            kp, vp, fp = shared_kv(xp, kv_norm, w_kv, w_f, b_f)
            ks_, vs_, fs_ = shared_kv(xs, kv_norm, w_kv, w_f, b_f)
    y_prompt = rms_norm(xp, final_norm)
    y_sample = rms_norm(xs, final_norm)
    return (y_prompt, y_sample, jnp.stack(conv_p), jnp.stack(h_p), kp, vp, fp,
            jnp.stack(conv_s), jnp.stack(h_s), ks_, vs_, fs_)
```

```cpp
#include <hip/hip_runtime.h>
#include <hip/hip_bf16.h>
#include <cstdio>
#include <cstdint>

#ifndef MK_PER_PHASE
#define MK_PER_PHASE 0
#endif

constexpr int DM = 2048, BP = 4, SP = 4096, BS = 16, SS = 64, PAST = 1024;
constexpr int TP = BP * SP, TS = BS * SS, T = TP + TS;
constexpr int DFF = 5632, DR = 2560, NH = 16, HD = 128, NRH = 10;
constexpr int SKS = PAST + SS;
constexpr float RMS_EPS = 1e-6f;
constexpr float ATT_SCALE = 0.08838834764831845f;
constexpr float INV_ATT_SCALE = 11.313708498984761f;

#define GAS __attribute__((address_space(1)))
#define LAS __attribute__((address_space(3)))
typedef unsigned short bf16;
typedef unsigned v4u __attribute__((ext_vector_type(4)));
typedef unsigned v2u __attribute__((ext_vector_type(2)));
typedef float f32x4 __attribute__((ext_vector_type(4)));
typedef float f32x2 __attribute__((ext_vector_type(2)));
typedef float f32x16 __attribute__((ext_vector_type(16)));
typedef short bf16x8 __attribute__((ext_vector_type(8)));
typedef short s16x4 __attribute__((ext_vector_type(4)));
typedef GAS unsigned gu32;

__device__ __forceinline__ unsigned cvt_pk_bf16(float lo, float hi) { unsigned r; asm volatile("v_cvt_pk_bf16_f32 %0, %1, %2" : "=v"(r) : "v"(lo), "v"(hi)); return r; }
__device__ __forceinline__ float bf_lo(unsigned w) { return __uint_as_float(w << 16); }
__device__ __forceinline__ float bf_hi(unsigned w) { return __uint_as_float(w & 0xffff0000u); }
__device__ __forceinline__ int lane_id_v() { int l; asm volatile("v_mbcnt_lo_u32_b32 %0, -1, 0\n\tv_mbcnt_hi_u32_b32 %0, -1, %0" : "=v"(l)); return l; }
__device__ __forceinline__ float fast_sigmoid(float x) { return __builtin_amdgcn_rcpf(1.0f + __builtin_amdgcn_exp2f(-1.4426950408889634f * x)); }

constexpr int NWAVES = 8;
constexpr size_t al4k(size_t x) { return (x + 4095) & ~(size_t)4095; }
constexpr size_t WS_CTL = 0, CTL_ZERO_BYTES = 1u << 20;
constexpr int CW_BAR = 4096;
constexpr size_t SSQ_OFF = 262144;
constexpr int NSSQ = 7;
static_assert(SSQ_OFF + (size_t)NSSQ * T * 4 <= CTL_ZERO_BYTES, "ssq inside the memset region");
constexpr size_t SZ_W1 = (size_t)2 * DFF * DM * 2, SZ_W2 = (size_t)DM * DFF * 2;
constexpr size_t WS_W1 = CTL_ZERO_BYTES;
constexpr size_t WS_W2 = WS_W1 + 4 * SZ_W1;
constexpr size_t WS_WAIN = WS_W2 + 4 * SZ_W2;
constexpr size_t WS_WG = WS_WAIN + (size_t)2 * DR * DM * 2;
constexpr size_t WS_WAOUT = WS_WG + (size_t)2 * DR * 256 * 2;
constexpr size_t WS_WKV = WS_WAOUT + (size_t)DM * DR * 2;
constexpr size_t WS_WQG = WS_WKV + (size_t)(2 * DM + 256) * DM * 2;
constexpr size_t WS_WO = WS_WQG + (size_t)2 * DM * DM * 2;
constexpr size_t WS_CL = WS_WO + (size_t)DM * DM * 2;
constexpr size_t WS_X = al4k(WS_CL + DR * 4);
constexpr size_t WS_XB = WS_X + (size_t)T * DM * 4;
constexpr size_t WS_H = WS_XB + (size_t)T * DM * 2;
constexpr size_t SZ_R = (size_t)T * DR * 2, SZ_D = (size_t)T * DM * 2;
constexpr size_t WS_U = WS_H, WS_UC = WS_H + SZ_R;
constexpr size_t WS_LA = WS_U;
constexpr size_t WS_Q = WS_H, WS_SG = WS_H + SZ_D;
constexpr size_t WS_GG = WS_H + (size_t)T * DFF * 2;
constexpr size_t WS_INP = WS_GG + SZ_R;
constexpr size_t WS_KP = WS_INP + SZ_R, WS_VP = WS_KP + (size_t)TP * DM * 2;
constexpr size_t WS_KS = WS_VP + (size_t)TP * DM * 2, WS_VS = WS_KS + (size_t)BS * SKS * DM * 2;
constexpr size_t WS_CP = WS_VS + (size_t)BS * SKS * DM * 2;
constexpr size_t WS_CS = WS_CP + (size_t)BP * NH * SP * 4;
constexpr size_t WS_END = WS_CS + (size_t)BS * NH * SKS * 4;
static_assert(2 * SZ_R <= (size_t)T * DFF * 2 && 2 * SZ_D <= (size_t)T * DFF * 2, "overlays fit in H");
constexpr size_t O_YP = 0, O_YS = O_YP + (size_t)TP * DM, O_CONVP = O_YS + (size_t)TS * DM, O_HP = O_CONVP + (size_t)BP * 3 * DR, O_KP = O_HP + (size_t)BP * DR,
                 O_VP = O_KP + (size_t)TP * DM, O_LFP = O_VP + (size_t)TP * DM, O_CONVS = O_LFP + (size_t)TP * NH, O_HS = O_CONVS + (size_t)BS * 3 * DR,
                 O_KS = O_HS + (size_t)BS * DR, O_VS = O_KS + (size_t)TS * DM, O_LFS = O_VS + (size_t)TS * DM, O_END = O_LFS + (size_t)TS * NH;

namespace pg8 {
#define PG8_LAS __attribute__((address_space(3)))
typedef unsigned short bf16_t;
constexpr int BM = 256, BK = 64, HALF = 128, HTB = HALF * BK * 2, STAGE_BYTES = 8 * HTB, NXCD = 8, WGM = 8;

__host__ __device__ __forceinline__ int lds_byte(int r, int c) { const int st = (r >> 4) * 2 + (c >> 5), rr = r & 15, cc = c & 31, ob = rr * 64 + cc * 2; return st * 1024 + (ob ^ (((ob >> 9) & 1) << 5)); }
__host__ __device__ __forceinline__ void stage_rc(int b, int& R, int& C) { const int st = b / 1024, sb = b % 1024, swz = sb ^ (((sb >> 9) & 1) << 5); R = (st >> 1) * 16 + swz / 64; C = (st & 1) * 32 + (swz % 64) / 2; }
__host__ __device__ __forceinline__ int perm32(int rho) { const int n = rho >> 4, i = rho & 15; return 8 * (i >> 2) + 4 * n + (i & 3); }

struct Unit { int pm, pn; };
struct Gemm { const bf16_t* A; const bf16_t* Bt; int M, N, K, lda; };

struct StaticOrder {
    int nM, nN, nwg, G, c;
    __device__ void init(int M, int N, int G_, int c_) { nM = M / BM; nN = N / BM; nwg = nM * nN; G = G_; c = c_; }
    __device__ bool next(int i, Unit& u) const {
        const long L = (long)i * G + c; if (L >= nwg) return false;
        int wgid = (int)L; { const int q = nwg / NXCD, r = nwg % NXCD, xcd = wgid % NXCD, off = wgid / NXCD; wgid = (xcd < r ? xcd * (q + 1) : r * (q + 1) + (xcd - r) * q) + off; }
        const int nig = WGM * nN, gid = wgid / nig, fm = gid * WGM, gsz = (nM - fm) < WGM ? (nM - fm) : WGM;
        u.pm = fm + ((wgid % nig) % gsz); u.pn = (wgid % nig) / gsz; return true;
    }
};

template <class Epi>
__device__ __forceinline__ void gemm_phase(PG8_LAS unsigned char* lds, const Gemm g, const StaticOrder& S, const Epi& E, const int wid) {
    const int lane = lane_id_v(), tid = wid * 64 + lane, wr = wid >> 2, wc = wid & 3, fr = lane & 15, fq = lane >> 4;
    const int K = g.K, nt = K / BK, lda = g.lda;
    unsigned voffA[2], voffB[2];
#pragma unroll
    for (int i = 0; i < 2; ++i) { int R, C; stage_rc(tid * 16 + i * 8192, R, C); const int Rb = Epi::PERM ? ((R & ~31) + perm32(R & 31)) : R;
        voffA[i] = (unsigned)(R * lda + C) * 2u; voffB[i] = (unsigned)(Rb * K + C) * 2u; }
    const size_t kstep = (size_t)(BK * 2);
    const size_t hstepA = (size_t)HALF * lda * 2, hstepB = (size_t)HALF * K * 2;
    const size_t tstepA = 2 * hstepA, tstepB = 2 * hstepB;
    const unsigned ldsw = (unsigned)wid * 1024u;
    const int aoff = lds_byte(wr * 64 + fr, fq * 8), boff = lds_byte(wc * 32 + fr, fq * 8);
#define PG8_SA(b, h) (((b) * 2 + (h)) * HTB)
#define PG8_SB(b, h) ((4 + (b) * 2 + (h)) * HTB)
#define PG8_STAGE(bufoff, gbase, voff) do { _Pragma("unroll") for (int _i = 0; _i < 2; ++_i) \
        __builtin_amdgcn_global_load_lds((const unsigned*)((const char*)(gbase) + (voff)[_i]), (PG8_LAS unsigned*)(lds + (bufoff) + ldsw + _i * 8192), 16, 0, 0); } while (0)
#define PG8_LDA(dst, b, h) do { _Pragma("unroll") for (int m = 0; m < 4; ++m) _Pragma("unroll") for (int k = 0; k < 2; ++k) dst[m][k] = *(const PG8_LAS bf16x8*)(lds + PG8_SA(b, h) + aoff + m * 2048 + k * 1024); } while (0)
#define PG8_LDB(dst, b, h) do { _Pragma("unroll") for (int n = 0; n < 2; ++n) _Pragma("unroll") for (int k = 0; k < 2; ++k) dst[n][k] = *(const PG8_LAS bf16x8*)(lds + PG8_SB(b, h) + boff + n * 2048 + k * 1024); } while (0)
#define PG8_MMA(ai, bj, At, Bt) do { __builtin_amdgcn_s_setprio(1); _Pragma("unroll") for (int m = 0; m < 4; ++m) _Pragma("unroll") for (int n = 0; n < 2; ++n) _Pragma("unroll") for (int k = 0; k < 2; ++k) \
        acc[ai][bj][m][n] = __builtin_amdgcn_mfma_f32_16x16x32_bf16(Bt[n][k], At[m][k], acc[ai][bj][m][n], 0, 0, 0); __builtin_amdgcn_s_setprio(0); } while (0)
#define PG8_WAIT_V(n) asm volatile("s_waitcnt vmcnt(" #n ")" ::: "memory")
#define PG8_WAIT_L(n) asm volatile("s_waitcnt lgkmcnt(" #n ")" ::: "memory")
#define PG8_BAR __builtin_amdgcn_s_barrier()
#define PG8_SCHED __builtin_amdgcn_sched_barrier(0)
    Unit cur, nxt; int ui = 0;
    if (!S.next(0, cur)) return;
    f32x4 acc[2][2][4][2];
#pragma unroll
    for (int a = 0; a < 2; ++a)
#pragma unroll
        for (int b = 0; b < 2; ++b)
#pragma unroll
            for (int m = 0; m < 4; ++m)
#pragma unroll
                for (int n = 0; n < 2; ++n) acc[a][b][m][n] = (f32x4){0.f, 0.f, 0.f, 0.f};
    bf16x8 At[4][2], B0[2][2], B1[2][2];
    const char* cA = (const char*)g.A + (size_t)cur.pm * tstepA + (size_t)Epi::acol(cur) * 2; const char* cB = (const char*)g.Bt + (size_t)cur.pn * tstepB;
    PG8_STAGE(PG8_SB(0, 0), cB, voffB); PG8_STAGE(PG8_SB(0, 1), cB + hstepB, voffB); PG8_STAGE(PG8_SA(0, 0), cA, voffA); PG8_STAGE(PG8_SA(0, 1), cA + hstepA, voffA);
    if (wr == 1) PG8_BAR;
    PG8_WAIT_V(2); PG8_BAR;
    PG8_STAGE(PG8_SB(1, 0), cB + kstep, voffB); PG8_STAGE(PG8_SA(1, 0), cA + kstep, voffA); PG8_STAGE(PG8_SB(1, 1), cB + hstepB + kstep, voffB);
    PG8_WAIT_V(6); PG8_BAR;
    for (;;) {
        const bool has_next = S.next(ui + 1, nxt);
        const char* nA = has_next ? (const char*)g.A + (size_t)nxt.pm * tstepA + (size_t)Epi::acol(nxt) * 2 : cA; const char* nB = has_next ? (const char*)g.Bt + (size_t)nxt.pn * tstepB : cB;
        for (int t = 0; t < nt; t += 2) {
            const bool last = (t == nt - 2);
            const char* a1 = cA + (size_t)(t + 1) * kstep;
            const char* a2 = last ? nA : cA + (size_t)(t + 2) * kstep; const char* b2 = last ? nB : cB + (size_t)(t + 2) * kstep;
            const char* a3 = a2 + kstep; const char* b3 = b2 + kstep;
            PG8_LDB(B0, 0, 0); PG8_LDB(B1, 0, 1); PG8_SCHED; PG8_LDA(At, 0, 0); PG8_STAGE(PG8_SA(1, 1), a1 + hstepA, voffA);
            PG8_WAIT_V(8); PG8_WAIT_L(0); PG8_BAR; PG8_MMA(0, 0, At, B0); PG8_MMA(0, 1, At, B1); PG8_BAR; PG8_SCHED;
            PG8_LDA(At, 0, 1); PG8_STAGE(PG8_SB(0, 0), b2, voffB); PG8_STAGE(PG8_SB(0, 1), b2 + hstepB, voffB); PG8_STAGE(PG8_SA(0, 0), a2, voffA);
            PG8_WAIT_V(8); PG8_WAIT_L(0); PG8_BAR; PG8_MMA(1, 0, At, B0); PG8_MMA(1, 1, At, B1); PG8_BAR; PG8_SCHED;
            PG8_LDB(B0, 1, 0); PG8_LDB(B1, 1, 1); PG8_SCHED; PG8_LDA(At, 1, 0); PG8_STAGE(PG8_SA(0, 1), a2 + hstepA, voffA);
            PG8_WAIT_V(8); PG8_WAIT_L(0); PG8_BAR; PG8_MMA(0, 0, At, B0); PG8_MMA(0, 1, At, B1); PG8_BAR; PG8_SCHED;
            PG8_LDA(At, 1, 1); PG8_STAGE(PG8_SB(1, 0), b3, voffB); PG8_STAGE(PG8_SB(1, 1), b3 + hstepB, voffB); PG8_STAGE(PG8_SA(1, 0), a3, voffA);
            PG8_WAIT_V(8); PG8_WAIT_L(0); PG8_BAR; PG8_MMA(1, 0, At, B0); PG8_MMA(1, 1, At, B1); PG8_BAR; PG8_SCHED;
        }
        if (wr == 0) PG8_BAR;
        E(acc, cur, wr, wc, fr, fq);
        if (!has_next) break;
#pragma unroll
        for (int a = 0; a < 2; ++a)
#pragma unroll
            for (int b = 0; b < 2; ++b)
#pragma unroll
                for (int m = 0; m < 4; ++m)
#pragma unroll
                    for (int n = 0; n < 2; ++n) acc[a][b][m][n] = (f32x4){0.f, 0.f, 0.f, 0.f};
        cur = nxt; cA = nA; cB = nB; ++ui;
        if (wr == 1) PG8_BAR;
    }
    PG8_WAIT_V(0);
    PG8_BAR;
#undef PG8_SA
#undef PG8_SB
#undef PG8_STAGE
#undef PG8_LDA
#undef PG8_LDB
#undef PG8_MMA
#undef PG8_WAIT_V
#undef PG8_WAIT_L
#undef PG8_BAR
#undef PG8_SCHED
}

__device__ __forceinline__ void row_scales(const float* ss, int row0, float (&sv)[8]) {
#pragma unroll
    for (int i = 0; i < 8; ++i) sv[i] = ss[row0 + (i >> 2) * HALF + (i & 3) * 16];
#pragma unroll
    for (int i = 0; i < 8; ++i) sv[i] = __builtin_amdgcn_rsqf(sv[i] * (1.0f / DM) + RMS_EPS);
}

struct EpiSwiGLU {
    static constexpr bool PERM = true;
    static __device__ __forceinline__ int acol(const Unit&) { return 0; }
    bf16_t* H; const float* ss;
    __device__ __forceinline__ void operator()(const f32x4 (&acc)[2][2][4][2], const Unit& u, int wr, int wc, int fr, int fq) const {
        const int row0 = u.pm * BM + wr * 64 + fr, col0 = u.pn * 128 + wc * 32 + 8 * fq;
        float sv[8]; row_scales(ss, row0, sv);
#pragma unroll
        for (int ai = 0; ai < 2; ++ai)
#pragma unroll
            for (int m = 0; m < 4; ++m) { const int row = row0 + ai * HALF + m * 16; const float s = sv[ai * 4 + m];
                float o[8];
#pragma unroll
                for (int n = 0; n < 2; ++n)
#pragma unroll
                    for (int j = 0; j < 4; ++j) { const float gt = acc[ai][0][m][n][j] * s, up = acc[ai][1][m][n][j] * s; o[4 * n + j] = gt * fast_sigmoid(gt) * up; }
                v4u w; w.x = cvt_pk_bf16(o[0], o[1]); w.y = cvt_pk_bf16(o[2], o[3]); w.z = cvt_pk_bf16(o[4], o[5]); w.w = cvt_pk_bf16(o[6], o[7]);
                *(v4u*)(H + (size_t)row * DFF + col0) = w; }
    }
};

struct EpiRes {
    static constexpr bool PERM = false;
    static __device__ __forceinline__ int acol(const Unit&) { return 0; }
    const float* xin_p; const float* xin_s; float* X; bf16_t* XB; float* ssq; float coef;
    __device__ __forceinline__ void operator()(const f32x4 (&acc)[2][2][4][2], const Unit& u, int wr, int wc, int fr, int fq) const {
        const int row0 = u.pm * BM + wr * 64 + fr, col0 = u.pn * BM + wc * 32 + 4 * fq;
        const float* xin = (u.pm < TP / BM) ? xin_p : (xin_s - (size_t)TP * DM);
        float rs[8];
#pragma unroll
        for (int ai = 0; ai < 2; ++ai)
#pragma unroll
            for (int m = 0; m < 4; ++m) { const int row = row0 + ai * HALF + m * 16; const size_t off = (size_t)row * DM + col0; float q = 0.f;
#pragma unroll
                for (int bj = 0; bj < 2; ++bj)
#pragma unroll
                    for (int n = 0; n < 2; ++n) { const f32x4 xo = *(const f32x4*)(xin + off + bj * HALF + n * 16); const f32x4 xn = xo + acc[ai][bj][m][n] * coef;
                        *(f32x4*)(X + off + bj * HALF + n * 16) = xn; q += (xn[0] * xn[0] + xn[1] * xn[1]) + (xn[2] * xn[2] + xn[3] * xn[3]);
                        v2u w; w.x = cvt_pk_bf16(xn[0], xn[1]); w.y = cvt_pk_bf16(xn[2], xn[3]); *(v2u*)(XB + off + bj * HALF + n * 16) = w; }
                q += __shfl_xor(q, 16); q += __shfl_xor(q, 32); rs[ai * 4 + m] = q;
                asm volatile("" ::: "memory"); }
#pragma unroll
        for (int j = 0; j < 2; ++j) { const float v = fq == 0 ? rs[4 * j] : (fq == 1 ? rs[4 * j + 1] : (fq == 2 ? rs[4 * j + 2] : rs[4 * j + 3]));
            const int row = row0 + j * HALF + fq * 16;
            __hip_atomic_fetch_add(ssq + row, v, __ATOMIC_RELAXED, __HIP_MEMORY_SCOPE_AGENT); }
    }
};

struct EpiAin {
    static constexpr bool PERM = true;
    static __device__ __forceinline__ int acol(const Unit&) { return 0; }
    bf16_t* GG; bf16_t* U; const float* ss;
    __device__ __forceinline__ void operator()(const f32x4 (&acc)[2][2][4][2], const Unit& u, int wr, int wc, int fr, int fq) const {
        const bool isu = u.pn >= 10; const int row0 = u.pm * BM + wr * 64 + fr, col0 = (isu ? u.pn - 10 : u.pn) * BM + wc * 32 + 8 * fq; bf16_t* dst = isu ? U : GG;
        float sv[8]; row_scales(ss, row0, sv);
#pragma unroll
        for (int ai = 0; ai < 2; ++ai)
#pragma unroll
            for (int m = 0; m < 4; ++m) { const int row = row0 + ai * HALF + m * 16; const float s = sv[ai * 4 + m];
#pragma unroll
                for (int bj = 0; bj < 2; ++bj) { float o[8];
#pragma unroll
                    for (int n = 0; n < 2; ++n)
#pragma unroll
                        for (int j = 0; j < 4; ++j) { const float x = acc[ai][bj][m][n][j] * s; float y = x;
                            if (!isu) { const float z = 1.5957691216057308f * (x + 0.044715f * x * x * x); y = x * fast_sigmoid(z); }
                            o[4 * n + j] = y; }
                    v4u w; w.x = cvt_pk_bf16(o[0], o[1]); w.y = cvt_pk_bf16(o[2], o[3]); w.z = cvt_pk_bf16(o[4], o[5]); w.w = cvt_pk_bf16(o[6], o[7]);
                    *(v4u*)(dst + (size_t)row * DR + col0 + bj * HALF) = w; } }
    }
};

struct EpiGates {
    static constexpr bool PERM = true;
    static __device__ __forceinline__ int acol(const Unit& u) { return (u.pn >> 1) * 256; }
    const bf16_t* UC; bf16_t* LA; bf16_t* INP; const float* gb; const float* cl;
    __device__ __forceinline__ void operator()(const f32x4 (&acc)[2][2][4][2], const Unit& u, int wr, int wc, int fr, int fq) const {
        const int row0 = u.pm * BM + wr * 64 + fr, ch0 = (u.pn >> 1) * 256 + (u.pn & 1) * 128 + wc * 32 + 8 * fq;
        float br[8], bi[8], cv[8];
#pragma unroll
        for (int n = 0; n < 2; ++n) { const f32x4 a = *(const f32x4*)(gb + ch0 + 4 * n), b = *(const f32x4*)(gb + DR + ch0 + 4 * n), c = *(const f32x4*)(cl + ch0 + 4 * n);
#pragma unroll
            for (int j = 0; j < 4; ++j) { br[4 * n + j] = a[j]; bi[4 * n + j] = b[j]; cv[4 * n + j] = c[j]; } }
#pragma unroll
        for (int ai = 0; ai < 2; ++ai)
#pragma unroll
            for (int m = 0; m < 4; ++m) { const int row = row0 + ai * HALF + m * 16; const size_t off = (size_t)row * DR + ch0;
                const v4u ucw = *(const v4u*)(UC + off); float uc[8] = {bf_lo(ucw.x), bf_hi(ucw.x), bf_lo(ucw.y), bf_hi(ucw.y), bf_lo(ucw.z), bf_hi(ucw.z), bf_lo(ucw.w), bf_hi(ucw.w)};
                float la[8], ip[8];
#pragma unroll
                for (int n = 0; n < 2; ++n)
#pragma unroll
                    for (int j = 0; j < 4; ++j) { const int e = 4 * n + j; const float r = fast_sigmoid(acc[ai][0][m][n][j] + br[e]), ig = fast_sigmoid(acc[ai][1][m][n][j] + bi[e]);
                        const float l = cv[e] * r; const float a2 = __builtin_amdgcn_exp2f(2.0f * 1.4426950408889634f * l); const float mult = __builtin_amdgcn_sqrtf(fmaxf(1.0f - a2, 0.f));
                        la[e] = l; ip[e] = mult * ig * uc[e]; }
                v4u w; w.x = cvt_pk_bf16(la[0], la[1]); w.y = cvt_pk_bf16(la[2], la[3]); w.z = cvt_pk_bf16(la[4], la[5]); w.w = cvt_pk_bf16(la[6], la[7]);
                *(v4u*)(LA + off) = w;
                v4u x; x.x = cvt_pk_bf16(ip[0], ip[1]); x.y = cvt_pk_bf16(ip[2], ip[3]); x.z = cvt_pk_bf16(ip[4], ip[5]); x.w = cvt_pk_bf16(ip[6], ip[7]);
                *(v4u*)(INP + off) = x; }
    }
};

struct EpiKV {
    static constexpr bool PERM = false;
    static __device__ __forceinline__ int acol(const Unit&) { return 0; }
    float* out; unsigned char* ws; const float* ss; const float* bfv;
    __device__ __forceinline__ void operator()(const f32x4 (&acc)[2][2][4][2], const Unit& u, int wr, int wc, int fr, int fq) const {
        const int row0 = u.pm * BM + wr * 64 + fr; const bool prompt = u.pm < TP / BM;
        float sv[8]; row_scales(ss, row0, sv);
        if (u.pn < 16) {
            const bool isv = u.pn >= 8; const int col0 = (u.pn & 7) * BM + wc * 32 + 4 * fq;
            const size_t fo = prompt ? (isv ? O_VP : O_KP) : (isv ? O_VS : O_KS), bo = prompt ? (isv ? WS_VP : WS_KP) : (isv ? WS_VS : WS_KS);
            float* of = out + fo; bf16_t* ob = (bf16_t*)(ws + bo);
#pragma unroll
            for (int ai = 0; ai < 2; ++ai)
#pragma unroll
                for (int m = 0; m < 4; ++m) { const int row = row0 + ai * HALF + m * 16; const float s = sv[ai * 4 + m];
                    size_t offf, offb;
                    if (prompt) { offf = (size_t)row * DM + col0; offb = offf; }
                    else { const int rsm = row - TP; offf = (size_t)rsm * DM + col0; offb = (size_t)((rsm >> 6) * SKS + PAST + (rsm & 63)) * DM + col0; }
#pragma unroll
                    for (int bj = 0; bj < 2; ++bj)
#pragma unroll
                        for (int n = 0; n < 2; ++n) { const f32x4 v = acc[ai][bj][m][n] * s; *(f32x4*)(of + offf + bj * HALF + n * 16) = v;
                            v2u w; w.x = cvt_pk_bf16(v[0], v[1]); w.y = cvt_pk_bf16(v[2], v[3]); *(v2u*)(ob + offb + bj * HALF + n * 16) = w; } }
        } else if (wc == 0) {
            const f32x4 b4 = *(const f32x4*)(bfv + 4 * fq);
            float* lf = out + (prompt ? O_LFP : O_LFS);
#pragma unroll
            for (int ai = 0; ai < 2; ++ai)
#pragma unroll
                for (int m = 0; m < 4; ++m) { const int row = row0 + ai * HALF + m * 16; const float s = sv[ai * 4 + m];
                    f32x4 o;
#pragma unroll
                    for (int j = 0; j < 4; ++j) { const float z = acc[ai][0][m][0][j] * s + b4[j]; o[j] = fminf(z, 0.f) - log1pf(__expf(-fabsf(z))); }
                    *(f32x4*)(lf + (size_t)(prompt ? row : row - TP) * NH + 4 * fq) = o; }
        }
    }
};

struct EpiQG {
    static constexpr bool PERM = true;
    static __device__ __forceinline__ int acol(const Unit&) { return 0; }
    bf16_t* Q; bf16_t* SG; const float* ss;
    __device__ __forceinline__ void operator()(const f32x4 (&acc)[2][2][4][2], const Unit& u, int wr, int wc, int fr, int fq) const {
        const bool isg = u.pn >= 8; const int row0 = u.pm * BM + wr * 64 + fr, col0 = (u.pn & 7) * BM + wc * 32 + 8 * fq; bf16_t* dst = isg ? SG : Q;
        float sv[8]; row_scales(ss, row0, sv);
#pragma unroll
        for (int ai = 0; ai < 2; ++ai)
#pragma unroll
            for (int m = 0; m < 4; ++m) { const int row = row0 + ai * HALF + m * 16; const float s = sv[ai * 4 + m];
#pragma unroll
                for (int bj = 0; bj < 2; ++bj) { float o[8];
#pragma unroll
                    for (int n = 0; n < 2; ++n)
#pragma unroll
                        for (int j = 0; j < 4; ++j) { const float x = acc[ai][bj][m][n][j] * s; o[4 * n + j] = isg ? fast_sigmoid(x) : x; }
                    v4u w; w.x = cvt_pk_bf16(o[0], o[1]); w.y = cvt_pk_bf16(o[2], o[3]); w.z = cvt_pk_bf16(o[4], o[5]); w.w = cvt_pk_bf16(o[6], o[7]);
                    *(v4u*)(dst + (size_t)row * DM + col0 + bj * HALF) = w; } }
    }
};
}

namespace fox {
constexpr int D = 128, NW = 8, QBLK = 32, KVBLK = 64, QB = NW * QBLK, PITCH = DM;
constexpr int SHM_V = KVBLK * D * 2, SHM_K = KVBLK * D * 2;
constexpr int OFF_WS = 2 * SHM_V + 2 * SHM_K, OFF_CB = OFF_WS + NW * 64 * 4, OFF_OST = OFF_CB + 2 * 64 * 4, OFF_QP = OFF_OST + NW * 4096, LDS_BYTES = OFF_QP + NW * 2048;
constexpr float SCALE = ATT_SCALE, THR = 8.f;

#define KSWZ(row, colB) ((row) * 256 + ((colB) ^ (((row) & 7) << 4)))
#define SBAR() __builtin_amdgcn_sched_barrier(0)
__device__ __forceinline__ int v_st(int k, int c) { const int kk = (k & ~0xC) | ((k & 4) << 1) | ((k & 8) >> 1); return ((kk >> 3) * 4 + (c >> 5)) * 512 + ((kk & 7) * 32 + (c & 31)) * 2; }
__device__ __forceinline__ int v_rd_base(int lane) { return ((lane & 3) << 3) | (((lane >> 2) & 3) << 6) | (((lane >> 4) & 1) << 5) | (((lane >> 5) & 1) << 8); }
constexpr int v_rd_off(int d0, int ks, int half) { return d0 * 512 + ks * 4096 + half * 2048; }
__device__ __forceinline__ int crow(int r, int hi) { return (r & 3) + 8 * (r >> 2) + 4 * hi; }
__device__ __forceinline__ bf16x8 load8(const bf16* p) { return *reinterpret_cast<const bf16x8*>(p); }

__device__ __forceinline__ void mask_tile(f32x16& p0, f32x16& p1, int dq) {
    const float NEG = -__builtin_inff();
#pragma unroll
    for (int r = 0; r < 16; ++r) {
        const int c = (r & 3) + 8 * (r >> 2);
        if (dq - c < 0) p0[r] = NEG;
        if (dq - c - 32 < 0) p1[r] = NEG;
    }
}
__device__ __forceinline__ void partialSM(f32x16& p0, f32x16& p1, float& m_reg, float& mn, float& alpha) {
    float pmax = p0[0]; for (int r = 1; r < 16; ++r) pmax = fmaxf(pmax, p0[r]); for (int r = 0; r < 16; ++r) pmax = fmaxf(pmax, p1[r]);
    { auto rr = __builtin_amdgcn_permlane32_swap(__float_as_uint(pmax), __float_as_uint(pmax), false, false);
      pmax = fmaxf(__uint_as_float(rr[0]), __uint_as_float(rr[1])); }
    constexpr float C2 = 1.4426950408889634f * SCALE;
    if (__builtin_expect(__all((pmax - m_reg) * SCALE <= THR), 1)) { mn = m_reg; alpha = 1.f; }
    else { mn = fmaxf(m_reg, pmax); alpha = __builtin_amdgcn_exp2f((m_reg - mn) * C2); m_reg = mn; }
    const float mnL = -mn * C2;
    for (int r = 0; r < 16; ++r) p0[r] = fmaf(p0[r], C2, mnL); for (int r = 0; r < 16; ++r) p1[r] = fmaf(p1[r], C2, mnL);
    for (int r = 0; r < 16; ++r) p0[r] = __builtin_amdgcn_exp2f(p0[r]);
}
__device__ __forceinline__ void finishSM(f32x16& p0, f32x16& p1, float alpha, float& l_reg, bf16x8& pa0, bf16x8& pa1, bf16x8& pa2, bf16x8& pa3) {
    for (int r = 0; r < 16; ++r) p1[r] = __builtin_amdgcn_exp2f(p1[r]);
    float ps = 0; for (int r = 0; r < 16; ++r) ps += p0[r]; for (int r = 0; r < 16; ++r) ps += p1[r];
    { auto rr = __builtin_amdgcn_permlane32_swap(__float_as_uint(ps), __float_as_uint(ps), false, false);
      ps = __uint_as_float(rr[0]) + __uint_as_float(rr[1]); }
    l_reg = l_reg * alpha + ps;
#define PK4(P, B_, OUT) do { unsigned a0 = cvt_pk_bf16(P[B_+0], P[B_+1]), a1 = cvt_pk_bf16(P[B_+2], P[B_+3]);                          \
        unsigned b0 = cvt_pk_bf16(P[B_+4], P[B_+5]), b1 = cvt_pk_bf16(P[B_+6], P[B_+7]);                                             \
        auto r0 = __builtin_amdgcn_permlane32_swap(a0, b0, false, false); auto r1 = __builtin_amdgcn_permlane32_swap(a1, b1, false, false); \
        v4u w = {r0[0], r1[0], r0[1], r1[1]}; OUT = *reinterpret_cast<bf16x8*>(&w); } while (0)
    PK4(p0, 0, pa0); PK4(p0, 8, pa1); PK4(p1, 0, pa2); PK4(p1, 8, pa3);
#undef PK4
}
template <int KB>
__device__ __forceinline__ void qkt(f32x16& p0, f32x16& p1, const char* K_lds, const char* cb_lds, int r32, int hi, const bf16x8* qr, const char* qpl) {
    const char* cbp = cb_lds + KB * 256 + hi * 16;
#pragma unroll
    for (int g = 0; g < 4; ++g) { const f32x4 c0 = *reinterpret_cast<const f32x4*>(cbp + g * 32), c1 = *reinterpret_cast<const f32x4*>(cbp + 128 + g * 32);
#pragma unroll
        for (int j = 0; j < 4; ++j) { p0[4 * g + j] = c0[j]; p1[4 * g + j] = c1[j]; } }
    const char* kb[4];
#pragma unroll
    for (int dd = 0; dd < 4; ++dd) kb[dd] = K_lds + KB * SHM_K + KSWZ(r32, (dd * 16 + hi * 8) * 2);
#pragma unroll
    for (int d0 = 0; d0 < 8; ++d0) { const char* a = kb[d0 & 3] + (d0 >> 2) * 128;
        bf16x8 b0 = *reinterpret_cast<const bf16x8*>(a);
        bf16x8 b1 = *reinterpret_cast<const bf16x8*>(a + 32 * 256);
        const bf16x8 q = d0 < 6 ? qr[d0] : *reinterpret_cast<const bf16x8*>(qpl + (d0 - 6) * 1024);
        p0 = __builtin_amdgcn_mfma_f32_32x32x16_bf16(b0, q, p0, 0, 0, 0);
        p1 = __builtin_amdgcn_mfma_f32_32x32x16_bf16(b1, q, p1, 0, 0, 0); }
}
template <int VB>
__device__ __forceinline__ void pv_tile(f32x16* o, int vb0, bf16x8 pa0, bf16x8 pa1, bf16x8 pa2, bf16x8 pa3) {
#define TRRD(dst, off) asm volatile("ds_read_b64_tr_b16 %0, %1 offset:%2" : "=&v"(dst) : "v"(vb0), "i"(off) : "memory")
#define PV_D0(d0) do { s16x4 l0, l1, l2, l3, h0, h1, h2, h3; constexpr int b_ = VB * SHM_V + v_rd_off(d0, 0, 0); \
        TRRD(l0, b_); TRRD(h0, b_ + 2048); TRRD(l1, b_ + 4096); TRRD(h1, b_ + 6144); TRRD(l2, b_ + 8192); TRRD(h2, b_ + 10240); TRRD(l3, b_ + 12288); TRRD(h3, b_ + 14336); \
        asm volatile("s_waitcnt lgkmcnt(0)" ::: "memory"); SBAR();   \
        o[d0] = __builtin_amdgcn_mfma_f32_32x32x16_bf16(pa0, (bf16x8){l0[0], l0[1], l0[2], l0[3], h0[0], h0[1], h0[2], h0[3]}, o[d0], 0, 0, 0);   \
        o[d0] = __builtin_amdgcn_mfma_f32_32x32x16_bf16(pa1, (bf16x8){l1[0], l1[1], l1[2], l1[3], h1[0], h1[1], h1[2], h1[3]}, o[d0], 0, 0, 0);   \
        o[d0] = __builtin_amdgcn_mfma_f32_32x32x16_bf16(pa2, (bf16x8){l2[0], l2[1], l2[2], l2[3], h2[0], h2[1], h2[2], h2[3]}, o[d0], 0, 0, 0);   \
        o[d0] = __builtin_amdgcn_mfma_f32_32x32x16_bf16(pa3, (bf16x8){l3[0], l3[1], l3[2], l3[3], h3[0], h3[1], h3[2], h3[3]}, o[d0], 0, 0, 0); } while (0)
    PV_D0(0); PV_D0(1); PV_D0(2); PV_D0(3);
#undef PV_D0
#undef TRRD
}

struct BlockRef { unsigned qo, ko, co; int P0, smp; };
#define BR_NROWS(r) ((r).smp ? SS : 256)
#define BR_SKV(r) ((r).smp ? SKS : SP)
#define BR_Q(r) ((const bf16*)(ws + WS_Q) + (r).qo)
#define BR_O(r) ((bf16*)(ws + WS_Q) + (r).qo)
#define BR_G(r) ((const bf16*)(ws + WS_SG) + (r).qo)
#define BR_K(r) ((const bf16*)(ws + ((r).smp ? WS_KS : WS_KP)) + (r).ko)
#define BR_V(r) ((const bf16*)(ws + ((r).smp ? WS_VS : WS_VP)) + (r).ko)
#define BR_C(r) ((const float*)(ws + ((r).smp ? WS_CS : WS_CP)) + (r).co)
struct Seam { bf16x8 qr[6]; bf16x8 qp0, qp1; bf16x8 st_v0, st_v1, st_k0, st_k1; float st_c; };

#define ROW(p, k0, rr) ((p) + (size_t)((k0) + (rr)) * PITCH + sc)
#define VMW() asm volatile("s_waitcnt vmcnt(0)" ::: "memory")
#define VMWN(n) asm volatile("s_waitcnt vmcnt(%0)" :: "i"(n) : "memory")
#define SLOAD_H(Kp, Vp, Cp, k0) do { S.st_v0 = load8(ROW(Vp, k0, sr)); S.st_v1 = load8(ROW(Vp, k0, 32 + sr));              \
                         S.st_k0 = load8(ROW(Kp, k0, sr)); S.st_k1 = load8(ROW(Kp, k0, 32 + sr)); if (tid < 64) S.st_c = (Cp)[(k0) + tid]; } while (0)
#define SWRITE_HK(bf) do { *(bf16x8*)(K_lds + (bf) * SHM_K + kws) = S.st_k0; *(bf16x8*)(K_lds + (bf) * SHM_K + kws + 32 * 256) = S.st_k1; \
                           if (tid < 64) *(float*)(cb_lds + (bf) * 256 + tid * 4) = S.st_c; } while (0)
#define SWRITE_HV(bf) do { *(bf16x8*)(V_lds + (bf) * SHM_V + vst0) = S.st_v0; *(bf16x8*)(V_lds + (bf) * SHM_V + vst1) = S.st_v1; } while (0)
#define SWRITE_H(bf) do { SWRITE_HV(bf); SWRITE_HK(bf); } while (0)

__device__ __forceinline__ void fox_prime(unsigned char* ws, const BlockRef& cur, char* lds, Seam& S, const int wid) {
    const int lane = lane_id_v(), tid = wid * 64 + lane, r32 = lane & 31, hi = lane >> 5;
    const int sr = tid >> 4, sc = (tid & 15) * 8, kws = KSWZ(sr, sc * 2); char* K_lds = lds + 2 * SHM_V; char* cb_lds = lds + OFF_CB;
    int qrow = wid * QBLK + r32; if (qrow > BR_NROWS(cur) - 1) qrow = BR_NROWS(cur) - 1;
    for (int d0 = 0; d0 < 6; ++d0) S.qr[d0] = load8(BR_Q(cur) + (size_t)qrow * PITCH + d0 * 16 + hi * 8);
    S.qp0 = load8(BR_Q(cur) + (size_t)qrow * PITCH + 6 * 16 + hi * 8); S.qp1 = load8(BR_Q(cur) + (size_t)qrow * PITCH + 7 * 16 + hi * 8);
    SLOAD_H(BR_K(cur), BR_V(cur), BR_C(cur), 0); VMW(); SWRITE_HK(0);
    { char* qpw = lds + OFF_QP + wid * 2048 + lane * 16; *(bf16x8*)qpw = S.qp0; *(bf16x8*)(qpw + 1024) = S.qp1; }
    __syncthreads();
}
__device__ __forceinline__ void fox_block(unsigned char* ws, const BlockRef& cur, const BlockRef& nxt, char* lds, Seam& S, const int wid, const int lane) {
    const int tid = wid * 64 + lane, r32 = lane & 31, hi = lane >> 5;
    int j_hi = (cur.P0 + QB - 1) / KVBLK + 1; if (j_hi > BR_SKV(cur) / KVBLK) j_hi = BR_SKV(cur) / KVBLK;
    const int NT = j_hi;
    const int qlo = cur.P0 + wid * QBLK, qm = qlo + r32 - 4 * hi;
    char* V_lds = lds; char* K_lds = lds + 2 * SHM_V; char* cb_lds = lds + OFF_CB;
    float* wsc = (float*)(lds + OFF_WS) + wid * 64; float* li_l = wsc, * al_l = wsc + 32;
    float m_reg = -1e30f, l_reg = 0; f32x16 o[4] = {};
    const int sr = tid >> 4, sc = (tid & 15) * 8, vst0 = v_st(sr, sc), vst1 = v_st(32 + sr, sc), kws = KSWZ(sr, sc * 2);
    const int vb0 = (int)(uintptr_t)V_lds + v_rd_base(lane);
    const bf16* Kh = BR_K(cur); const bf16* Vh = BR_V(cur); const float* Ch = BR_C(cur);
    const char* qpl = lds + OFF_QP + wid * 2048 + lane * 16;
#define RESC(a) do { if (__any((a) < 1.f)) { if (hi == 0) al_l[r32] = (a); asm volatile("s_waitcnt lgkmcnt(0)" ::: "memory");              \
                     for (int d_ = 0; d_ < 4; ++d_) for (int r = 0; r < 16; ++r) o[d_][r] *= al_l[crow(r, hi)]; } } while (0)
#define KBASE(t) ((t) * KVBLK)
#define MASKT(P0_, P1_, t) do { const int kb_ = KBASE(t); if (kb_ + KVBLK - 1 > qlo) mask_tile(P0_, P1_, qm - kb_); } while (0)
    constexpr int NQL = 8;
#define SEAM_K0() do { VMWN(NQL); SWRITE_HK(0); SBAR(); } while (0)
    f32x16 pA0, pA1, pB0, pB1; float mnA, mnB, alA, alB; bf16x8 pa0, pa1, pa2, pa3;
    SWRITE_HV(0); SBAR();
    if (NT > 1) { SLOAD_H(Kh, Vh, Ch, KBASE(1)); }
    SBAR(); qkt<0>(pA0, pA1, K_lds, cb_lds, r32, hi, S.qr, qpl);
    MASKT(pA0, pA1, 0); partialSM(pA0, pA1, m_reg, mnA, alA);
    if (NT > 1) { VMW(); SWRITE_H(1); }
    __syncthreads();
#define HALF_STEP(PX0, PX1, mnX, alX, PY0, PY1, alY, t, KB, VB, SB) do {                                                      \
        SBAR(); qkt<KB>(PX0, PX1, K_lds, cb_lds, r32, hi, S.qr, qpl);                                                         \
        finishSM(PY0, PY1, alY, l_reg, pa0, pa1, pa2, pa3); SBAR();                                                           \
        if ((t) + 1 < NT) { SLOAD_H(Kh, Vh, Ch, KBASE((t) + 1)); SBAR(); }                                                   \
        pv_tile<VB>(o, vb0, pa0, pa1, pa2, pa3); MASKT(PX0, PX1, (t)); partialSM(PX0, PX1, m_reg, mnX, alX);                 \
        __syncthreads();                                                                                                      \
        if ((t) + 1 < NT) { VMW(); SWRITE_H(SB); }                                                                            \
        RESC(alX); __syncthreads(); } while (0)
    for (int t = 1; t + 1 < NT; t += 2) {
        HALF_STEP(pB0, pB1, mnB, alB, pA0, pA1, alA, t, 1, 0, 0);
        HALF_STEP(pA0, pA1, mnA, alA, pB0, pB1, alB, t + 1, 0, 1, 1);
    }
    const bool even = (NT & 1) == 0;
    if (even) { SBAR(); qkt<1>(pB0, pB1, K_lds, cb_lds, r32, hi, S.qr, qpl); SBAR(); }
    int qrow_n = wid * QBLK + r32; if (qrow_n > BR_NROWS(nxt) - 1) qrow_n = BR_NROWS(nxt) - 1;
    SLOAD_H(BR_K(nxt), BR_V(nxt), BR_C(nxt), 0); SBAR();
#pragma unroll
    for (int d0 = 0; d0 < 6; ++d0) S.qr[d0] = load8(BR_Q(nxt) + (size_t)qrow_n * PITCH + d0 * 16 + hi * 8);
    S.qp0 = load8(BR_Q(nxt) + (size_t)qrow_n * PITCH + 6 * 16 + hi * 8); S.qp1 = load8(BR_Q(nxt) + (size_t)qrow_n * PITCH + 7 * 16 + hi * 8);
    SBAR();
    finishSM(pA0, pA1, alA, l_reg, pa0, pa1, pa2, pa3); SBAR();
    pv_tile<0>(o, vb0, pa0, pa1, pa2, pa3);
    if (even) { MASKT(pB0, pB1, NT - 1); partialSM(pB0, pB1, m_reg, mnB, alB); __syncthreads(); RESC(alB);
        finishSM(pB0, pB1, alB, l_reg, pa0, pa1, pa2, pa3); SBAR(); pv_tile<1>(o, vb0, pa0, pa1, pa2, pa3); }
    SBAR(); SEAM_K0();
    if (hi == 0) li_l[r32] = l_reg; asm volatile("s_waitcnt lgkmcnt(0)" ::: "memory");
    if (wid * QBLK < BR_NROWS(cur)) {
        int lane_e = lane, wid_e = wid; asm volatile("" : "+v"(lane_e), "+s"(wid_e));
        const int r32_e = lane_e & 31, hi_e = lane_e >> 5;
        const float* li_e = (const float*)(lds + OFF_WS) + wid_e * 64 + 4 * hi_e;
        float rli[16];
#pragma unroll
        for (int r = 0; r < 16; ++r) rli[r] = __builtin_amdgcn_rcpf(li_e[(r & 3) + 8 * (r >> 2)]);
        bf16* stg = (bf16*)(lds + OFF_OST) + wid_e * 2048;
        bf16* stw = stg + 4 * hi_e * 64 + r32_e;
        const size_t lo_ = (size_t)(wid_e * QBLK + (lane_e >> 3)) * PITCH + (lane_e & 7) * 8;
        bf16* Ow = BR_O(cur) + lo_; const bf16* Gw = BR_G(cur) + lo_;
        const bf16* str = stg + (lane_e >> 3) * 64 + (lane_e & 7) * 8;
#pragma unroll
        for (int hf = 0; hf < 2; ++hf) {
            v4u gq[4];
#pragma unroll
            for (int i = 0; i < 4; ++i) gq[i] = *(const v4u*)(Gw + (size_t)i * 8 * PITCH + hf * 64);
#pragma unroll
            for (int r = 0; r < 16; ++r) {
#pragma unroll
                for (int d0 = 0; d0 < 2; ++d0) stw[((r & 3) + 8 * (r >> 2)) * 64 + d0 * 32] = (bf16)(cvt_pk_bf16(o[2 * hf + d0][r] * rli[r], 0.f) & 0xffffu); }
            asm volatile("s_waitcnt lgkmcnt(0)" ::: "memory");
#pragma unroll
            for (int i = 0; i < 4; ++i) { const v4u v = *(const v4u*)(str + i * 8 * 64); const v4u gg = gq[i];
                v4u w; w.x = cvt_pk_bf16(bf_lo(v.x) * bf_lo(gg.x), bf_hi(v.x) * bf_hi(gg.x)); w.y = cvt_pk_bf16(bf_lo(v.y) * bf_lo(gg.y), bf_hi(v.y) * bf_hi(gg.y));
                w.z = cvt_pk_bf16(bf_lo(v.z) * bf_lo(gg.z), bf_hi(v.z) * bf_hi(gg.z)); w.w = cvt_pk_bf16(bf_lo(v.w) * bf_lo(gg.w), bf_hi(v.w) * bf_hi(gg.w));
                *(v4u*)(Ow + (size_t)i * 8 * PITCH + hf * 64) = w; }
            asm volatile("s_waitcnt lgkmcnt(0)" ::: "memory");
        }
    }
    { char* qpw = lds + OFF_QP + wid * 2048 + lane * 16; *(bf16x8*)qpw = S.qp0; *(bf16x8*)(qpw + 1024) = S.qp1; }
    __syncthreads();
#undef RESC
#undef KBASE
#undef MASKT
#undef SEAM_K0
#undef HALF_STEP
}
#undef ROW
#undef VMW
#undef VMWN
#undef SLOAD_H
#undef SWRITE_HK
#undef SWRITE_HV
#undef SWRITE_H
}

constexpr int RING_OFF = 0, RING_BYTES = 131072;
constexpr int LDSCTL_OFF = RING_BYTES, MISC_OFF = LDSCTL_OFF + 320;
constexpr int LDS_BYTES = 147456;
static_assert(fox::LDS_BYTES <= RING_BYTES, "attention scratch fits the ring region");

#define RLX_AGENT __ATOMIC_RELAXED, __HIP_MEMORY_SCOPE_AGENT
#define LDS_WAIT() asm volatile("s_waitcnt lgkmcnt(0)" ::: "memory")
#define VM_WAIT() asm volatile("s_waitcnt vmcnt(0)" ::: "memory")

#define XB_TMO      128
#define XB_XCNT(j)  (256  + 64 * (j))
#define XB_XSUB(j)  (1280 + 64 * (j))
#define XB_XGEN(j)  (2304 + 64 * (j))
#define XB_TOP      3328
#define XB_TOPGEN   3392
#define XCD_BAR_WORDS 3456
#define XB_SPIN_CAP (1u << 18)
__device__ __forceinline__ unsigned xb_ld(unsigned* p)              { return __hip_atomic_load(p, __ATOMIC_RELAXED, __HIP_MEMORY_SCOPE_AGENT); }
__device__ __forceinline__ unsigned xb_add(unsigned* p, unsigned v) { return __hip_atomic_fetch_add(p, v, __ATOMIC_RELAXED, __HIP_MEMORY_SCOPE_AGENT); }
__device__ __forceinline__ unsigned xb_xcc_id() { return (unsigned)__builtin_amdgcn_s_getreg((3 << 11) | 20) & 0xFu; }
#define XB_SPIN(cond, bar) do { unsigned _sp = 0; while (cond) { __builtin_amdgcn_s_sleep(1); \
    if ((++_sp & 255u) == 0u) { if (xb_ld(&(bar)[XB_TMO])) break; if (_sp > XB_SPIN_CAP) { atomicAdd(&(bar)[XB_TMO], 1u); break; } } } } while (0)
struct XcdBarrier { unsigned* bar; unsigned x; volatile LAS unsigned* st; };
__device__ __forceinline__ XcdBarrier xcd_barrier_post(unsigned* bar, volatile LAS unsigned* st) {
    XcdBarrier b; b.bar = bar; b.x = xb_xcc_id(); b.st = st;
    if (threadIdx.x == 0) (void)xb_add(&bar[XB_XCNT(b.x)], 1u);
    return b;
}
__device__ __forceinline__ void xcd_barrier_complete(unsigned* bar, unsigned x, unsigned& nloc, unsigned& nx) {
    const unsigned G = gridDim.x * gridDim.y * gridDim.z;
    unsigned sum, cnt, mine, sp = 0u;
    for (;;) {
        sum = 0u; cnt = 0u; mine = 0u;
#pragma unroll
        for (unsigned j = 0; j < 16; ++j) { const unsigned c = xb_ld(&bar[XB_XCNT(j)]); sum += c; cnt += (c > 0u) ? 1u : 0u; mine = (j == x) ? c : mine; }
        if (sum == G) break;
        __builtin_amdgcn_s_sleep(1);
        if ((++sp & 255u) == 0u) { if (xb_ld(&bar[XB_TMO])) break; if (sp > XB_SPIN_CAP) { atomicAdd(&bar[XB_TMO], 1u); break; } }
    }
    nloc = mine > 0u ? mine : 1u; nx = cnt > 0u ? cnt : 1u;
}
__device__ __forceinline__ void xcd_barrier(const XcdBarrier& b) {
    asm volatile("s_waitcnt vmcnt(0)" ::: "memory");
    __syncthreads();
    if (threadIdx.x == 0) {
        unsigned* bar = b.bar;
        __builtin_amdgcn_s_waitcnt(0);
        unsigned nloc = b.st[0], nx = b.st[1];
        if (nloc == 0u) { xcd_barrier_complete(bar, b.x, nloc, nx); b.st[0] = nloc; b.st[1] = nx; }
        const unsigned old = xb_add(&bar[XB_XSUB(b.x)], 1u);
        const unsigned gen = old / nloc;
        if (old + 1u == (gen + 1u) * nloc) {
            __builtin_amdgcn_fence(__ATOMIC_RELEASE, "agent");
            asm volatile("s_waitcnt vmcnt(0)" ::: "memory");
            const unsigned og = xb_add(&bar[XB_TOP], 1u);
            const unsigned tg = og / nx;
            if (og + 1u == (tg + 1u) * nx) xb_add(&bar[XB_TOPGEN], 1u);
            else XB_SPIN(xb_ld(&bar[XB_TOPGEN]) == tg, bar);
            __builtin_amdgcn_fence(__ATOMIC_ACQUIRE, "agent");
            xb_add(&bar[XB_XGEN(b.x)], 1u);
            asm volatile("s_waitcnt vmcnt(0)" ::: "memory");
        } else {
            XB_SPIN(xb_ld(&bar[XB_XGEN(b.x)]) == gen, bar);
            __builtin_amdgcn_fence(__ATOMIC_ACQUIRE, "agent");
            asm volatile("s_waitcnt vmcnt(0)" ::: "memory");
        }
    }
    __syncthreads();
}

__device__ __forceinline__ float wave_sum(float v) {
#pragma unroll
    for (int o = 1; o < 64; o <<= 1) v += __shfl_xor(v, o);
    return v;
}
__device__ __forceinline__ void tr_item(const float* W, int N, bf16* WT, int KP_, const float* gain, int k0, int n0, int drow0, LAS float* scr, int lane) {
#pragma unroll 8
    for (int i = 0; i < 32; ++i) { const int kk = 2 * i + (lane >> 5); scr[kk * 33 + (lane & 31)] = W[(size_t)(k0 + kk) * N + n0 + (lane & 31)]; }
    LDS_WAIT(); asm volatile("" ::: "memory");
    const int c = lane & 7;
    float gv[8];
    if (gain) { const f32x4 a = *(const f32x4*)(gain + k0 + 8 * c), b = *(const f32x4*)(gain + k0 + 8 * c + 4);
        gv[0] = a[0]; gv[1] = a[1]; gv[2] = a[2]; gv[3] = a[3]; gv[4] = b[0]; gv[5] = b[1]; gv[6] = b[2]; gv[7] = b[3]; }
    else {
#pragma unroll
        for (int i = 0; i < 8; ++i) gv[i] = 1.f; }
#pragma unroll
    for (int j = 0; j < 4; ++j) { const int n = (lane >> 3) + 8 * j; const LAS float* s = scr + (8 * c) * 33 + n;
        v4u o; o.x = cvt_pk_bf16(s[0 * 33] * gv[0], s[1 * 33] * gv[1]); o.y = cvt_pk_bf16(s[2 * 33] * gv[2], s[3 * 33] * gv[3]);
        o.z = cvt_pk_bf16(s[4 * 33] * gv[4], s[5 * 33] * gv[5]); o.w = cvt_pk_bf16(s[6 * 33] * gv[6], s[7 * 33] * gv[7]);
        *(v4u*)(WT + (size_t)(drow0 + n) * KP_ + k0 + 8 * c) = o; }
    LDS_WAIT(); asm volatile("" ::: "memory");
}
__device__ __forceinline__ void tr_matrix(const float* W, int K, int N, bf16* WT, const float* gain, int mode, int row_off, LAS float* scr, int gw, int NGW, int lane) {
    const int nblk = N / 32, nitems = (K / 64) * nblk;
    for (int it = gw; it < nitems; it += NGW) { const int kb = it / nblk, nb = it - kb * nblk, n0 = nb * 32; int drow0;
        if (mode == 1) { const int up = n0 >= DFF ? 1 : 0, j = n0 - up * DFF; drow0 = (j >> 7) * 256 + up * 128 + (j & 127); } else drow0 = row_off + n0;
        tr_item(W, N, WT, K, gain, kb * 64, n0, drow0, scr, lane); }
}

struct Args { const float* in[26]; float* out; unsigned char* ws; int ph_lo, ph_hi; };

struct Frame {
    LAS unsigned char* lds; volatile LAS unsigned* MISC;
    int wave, vcu, G;
    unsigned char* ws; float* out;
};
#define IN_(k) (args.in[k])

__device__ __forceinline__ void p0_prologue(const Args& args, Frame& F) {
    LAS float* scr = (LAS float*)(F.lds + RING_OFF + F.wave * 16384);
    const int lane = lane_id_v(); const int gw = F.vcu * NWAVES + F.wave, NGW = F.G * NWAVES;
    unsigned char* ws = F.ws;
    for (int f = 0; f < 4; ++f) {
        tr_matrix(IN_(8) + (size_t)f * DM * 2 * DFF, DM, 2 * DFF, (bf16*)(ws + WS_W1 + f * SZ_W1), IN_(7) + (size_t)f * DM, 1, 0, scr, gw, NGW, lane);
        tr_matrix(IN_(9) + (size_t)f * DFF * DM, DFF, DM, (bf16*)(ws + WS_W2 + f * SZ_W2), nullptr, 0, 0, scr, gw, NGW, lane);
    }
    tr_matrix(IN_(11), DM, 2 * DR, (bf16*)(ws + WS_WAIN), IN_(10), 0, 0, scr, gw, NGW, lane);
    for (int gh = 0; gh < 2 * NRH; ++gh) { const int g = gh / NRH, hb = gh % NRH;
        const float* W = IN_(14) + (size_t)gh * 256 * 256; bf16* WT = (bf16*)(ws + WS_WG);
        for (int it = gw; it < 4 * 8; it += NGW) { const int kb = it / 8, nb = it % 8, n0 = nb * 32;
            tr_item(W, 256, WT, 256, nullptr, kb * 64, n0, (2 * hb + (n0 >> 7)) * 256 + g * 128 + (n0 & 127), scr, lane); } }
    tr_matrix(IN_(17), DR, DM, (bf16*)(ws + WS_WAOUT), nullptr, 0, 0, scr, gw, NGW, lane);
    tr_matrix(IN_(19), DM, 2 * DM, (bf16*)(ws + WS_WKV), IN_(18), 0, 0, scr, gw, NGW, lane);
    tr_matrix(IN_(23), DM, 2 * DM, (bf16*)(ws + WS_WQG), IN_(22), 0, 0, scr, gw, NGW, lane);
    tr_matrix(IN_(24), DM, DM, (bf16*)(ws + WS_WO), nullptr, 0, 0, scr, gw, NGW, lane);
    {
        const int gt = gw * 64 + lane, NGT = NGW * 64; bf16* WT = (bf16*)(ws + WS_WKV) + (size_t)2 * DM * DM;
        for (int i = gt; i < 256 * DM; i += NGT) { const int n = i / DM, k = i - n * DM; float v = 0.f; if (n < NH) v = IN_(20)[(size_t)k * NH + n] * IN_(18)[k];
            WT[i] = (bf16)(cvt_pk_bf16(v, 0.f) & 0xffffu); }
        float* cl = (float*)(ws + WS_CL);
        for (int i = gt; i < DR; i += NGT) cl[i] = -8.0f * log1pf(expf(-IN_(16)[i]));
    }
    { float* ssq0 = (float*)(ws + SSQ_OFF); bf16* XB = (bf16*)(ws + WS_XB);
      for (int m = gw; m < T; m += NGW) { const float* xr = (m < TP) ? IN_(0) + (size_t)m * DM : IN_(1) + (size_t)(m - TP) * DM;
        float s = 0.f;
#pragma unroll
        for (int j = 0; j < 8; ++j) { const f32x4 v = *((const f32x4*)xr + lane + 64 * j); s += (v[0] * v[0] + v[1] * v[1]) + (v[2] * v[2] + v[3] * v[3]);
            v2u w; w.x = cvt_pk_bf16(v[0], v[1]); w.y = cvt_pk_bf16(v[2], v[3]); *((v2u*)(XB + (size_t)m * DM) + lane + 64 * j) = w; }
        s = wave_sum(s); if (lane == 0) ssq0[m] = s; } }
    { for (int it = gw; it < 2 * BS * PAST; it += NGW) { const int kv = it / (BS * PAST), r = it - kv * (BS * PAST), b = r / PAST, p = r - b * PAST;
        const float* src = IN_(4 + kv) + (size_t)r * DM; bf16* dst = (bf16*)(ws + (kv ? WS_VS : WS_KS)) + (size_t)(b * SKS + p) * DM;
#pragma unroll
        for (int j = 0; j < 8; ++j) { const f32x4 v = *((const f32x4*)src + lane + 64 * j); v2u w; w.x = cvt_pk_bf16(v[0], v[1]); w.y = cvt_pk_bf16(v[2], v[3]); *((v2u*)dst + lane + 64 * j) = w; } } }
}

__device__ __forceinline__ void conv_phase(const Args& args, Frame& F) {
    const bf16* U = (const bf16*)(F.ws + WS_U); bf16* UC = (bf16*)(F.ws + WS_UC);
    const float* cw = IN_(12); const float* cb = IN_(13); const float* stc = IN_(2);
    const int gt = (F.vcu * NWAVES + F.wave) * 64 + lane_id_v(), NGT = F.G * NWAVES * 64;
    constexpr int CG = DR / 8, CH = 32;
    constexpr int NIT = (T / CH) * CG;
    for (int it = gt; it < NIT; it += NGT) {
        const int cg = it % CG, chunk = it / CG, c0 = cg * 8, row0 = chunk * CH;
        const bool prompt = row0 < TP; const int t0 = prompt ? (row0 & (SP - 1)) : ((row0 - TP) & (SS - 1)); const int slen = prompt ? SP : SS;
        float w[4][8], bb[8], h[3][8];
#pragma unroll
        for (int k = 0; k < 4; ++k) { const f32x4 a = *(const f32x4*)(cw + k * DR + c0), b = *(const f32x4*)(cw + k * DR + c0 + 4);
#pragma unroll
            for (int j = 0; j < 4; ++j) { w[k][j] = a[j]; w[k][4 + j] = b[j]; } }
        { const f32x4 a = *(const f32x4*)(cb + c0), b = *(const f32x4*)(cb + c0 + 4);
#pragma unroll
            for (int j = 0; j < 4; ++j) { bb[j] = a[j]; bb[4 + j] = b[j]; } }
        if (t0 == 0) {
            if (prompt) {
#pragma unroll
                for (int k = 0; k < 3; ++k)
#pragma unroll
                    for (int j = 0; j < 8; ++j) h[k][j] = 0.f; }
            else { const int b = (row0 - TP) / SS;
#pragma unroll
                for (int k = 0; k < 3; ++k) { const f32x4 a = *(const f32x4*)(stc + ((size_t)b * 3 + k) * DR + c0), bq = *(const f32x4*)(stc + ((size_t)b * 3 + k) * DR + c0 + 4);
#pragma unroll
                    for (int j = 0; j < 4; ++j) { h[k][j] = a[j]; h[k][4 + j] = bq[j]; } } }
        } else {
#pragma unroll
            for (int k = 0; k < 3; ++k) { const v4u q = *(const v4u*)(U + (size_t)(row0 - 3 + k) * DR + c0);
                h[k][0] = bf_lo(q.x); h[k][1] = bf_hi(q.x); h[k][2] = bf_lo(q.y); h[k][3] = bf_hi(q.y); h[k][4] = bf_lo(q.z); h[k][5] = bf_hi(q.z); h[k][6] = bf_lo(q.w); h[k][7] = bf_hi(q.w); }
        }
#pragma unroll 4
        for (int r = 0; r < CH; ++r) { const v4u q = *(const v4u*)(U + (size_t)(row0 + r) * DR + c0);
            float x[8] = {bf_lo(q.x), bf_hi(q.x), bf_lo(q.y), bf_hi(q.y), bf_lo(q.z), bf_hi(q.z), bf_lo(q.w), bf_hi(q.w)}; float o[8];
#pragma unroll
            for (int j = 0; j < 8; ++j) { o[j] = bb[j] + w[0][j] * h[0][j] + w[1][j] * h[1][j] + w[2][j] * h[2][j] + w[3][j] * x[j]; h[0][j] = h[1][j]; h[1][j] = h[2][j]; h[2][j] = x[j]; }
            v4u ow; ow.x = cvt_pk_bf16(o[0], o[1]); ow.y = cvt_pk_bf16(o[2], o[3]); ow.z = cvt_pk_bf16(o[4], o[5]); ow.w = cvt_pk_bf16(o[6], o[7]);
            *(v4u*)(UC + (size_t)(row0 + r) * DR + c0) = ow; }
        if (t0 + CH == slen) {
            float* dst = prompt ? (F.out + O_CONVP + (size_t)(row0 / SP) * 3 * DR) : (F.out + O_CONVS + (size_t)((row0 - TP) / SS) * 3 * DR);
#pragma unroll
            for (int k = 0; k < 3; ++k) { *(f32x4*)(dst + (size_t)k * DR + c0) = (f32x4){h[k][0], h[k][1], h[k][2], h[k][3]}; *(f32x4*)(dst + (size_t)k * DR + c0 + 4) = (f32x4){h[k][4], h[k][5], h[k][6], h[k][7]}; }
        }
    }
}

__device__ __forceinline__ void scan_phase(const Args& args, Frame& F) {
    const bf16* LA = (const bf16*)(F.ws + WS_LA); const bf16* INP = (const bf16*)(F.ws + WS_INP); bf16* GG = (bf16*)(F.ws + WS_GG);
    LAS float* sA = (LAS float*)(F.lds + RING_OFF); LAS float* sH = sA + 8 * 64; const int lane = lane_id_v();
    constexpr float L2E = 1.4426950408889634f;
    constexpr int NPU = BP * (DR / 64), NSU = (BS * (DR / 64)) / 8;
    for (int unit = blockIdx.x; unit < NPU + NSU; unit += F.G) {
        if (unit < NPU) {
            const int b = unit / (DR / 64), cg = unit % (DR / 64), c = cg * 64 + lane, seg = F.wave;
            const size_t base = ((size_t)b * SP + (size_t)seg * 512) * DR + c;
            float A = 1.f, Hh = 0.f;
#pragma unroll 16
            for (int t = 0; t < 512; ++t) { const float la = __uint_as_float((unsigned)LA[base + (size_t)t * DR] << 16), x = __uint_as_float((unsigned)INP[base + (size_t)t * DR] << 16);
                const float a = __builtin_amdgcn_exp2f(la * L2E); Hh = a * Hh + x; A *= a; }
            sA[seg * 64 + lane] = A; sH[seg * 64 + lane] = Hh;
            __syncthreads();
            float h = 0.f;
            for (int s = 0; s < seg; ++s) h = sA[s * 64 + lane] * h + sH[s * 64 + lane];
#pragma unroll 16
            for (int t = 0; t < 512; ++t) { const float la = __uint_as_float((unsigned)LA[base + (size_t)t * DR] << 16), x = __uint_as_float((unsigned)INP[base + (size_t)t * DR] << 16);
                const float a = __builtin_amdgcn_exp2f(la * L2E); h = a * h + x;
                const float gg = __uint_as_float((unsigned)GG[base + (size_t)t * DR] << 16);
                GG[base + (size_t)t * DR] = (bf16)(cvt_pk_bf16(h * gg, 0.f) & 0xffffu); }
            if (seg == 7) F.out[O_HP + (size_t)b * DR + c] = h;
            __syncthreads();
        } else {
            const int su = (unit - NPU) * 8 + F.wave, b = su / (DR / 64), cg = su % (DR / 64), c = cg * 64 + lane;
            const size_t base = ((size_t)TP + (size_t)b * SS) * DR + c;
            float h = IN_(3)[(size_t)b * DR + c];
#pragma unroll 16
            for (int t = 0; t < SS; ++t) { const float la = __uint_as_float((unsigned)LA[base + (size_t)t * DR] << 16), x = __uint_as_float((unsigned)INP[base + (size_t)t * DR] << 16);
                const float a = __builtin_amdgcn_exp2f(la * L2E); h = a * h + x;
                const float gg = __uint_as_float((unsigned)GG[base + (size_t)t * DR] << 16);
                GG[base + (size_t)t * DR] = (bf16)(cvt_pk_bf16(h * gg, 0.f) & 0xffffu); }
            F.out[O_HS + (size_t)b * DR + c] = h;
        }
    }
}

__device__ __forceinline__ void cumsum_items(const Args& args, Frame& F) {
    const int item = (F.G - 1 - (int)blockIdx.x) * NWAVES + F.wave;
    const int lane = lane_id_v();
    for (int it = item; it < BP * NH + BS * NH; it += F.G * NWAVES) {
        if (it < BP * NH) { const int b = it / NH, h = it % NH; const float* lf = F.out + O_LFP + ((size_t)b * SP + (size_t)lane * 64) * NH + h;
            float s = 0.f;
            for (int t = 0; t < 64; ++t) s += lf[(size_t)t * NH];
            float incl = s;
#pragma unroll
            for (int o = 1; o < 64; o <<= 1) { const float v = __shfl_up(incl, o); if (lane >= o) incl += v; }
            float run = incl - s; float* dst = (float*)(F.ws + WS_CP) + ((size_t)b * NH + h) * SP + lane * 64;
            for (int t = 0; t < 64; ++t) { run += lf[(size_t)t * NH]; dst[t] = -run * INV_ATT_SCALE; }
        } else { const int r = it - BP * NH, b = r / NH, h = r % NH; const float* cl = IN_(6) + (size_t)b * PAST * NH + h; const float* lf = F.out + O_LFS + (size_t)b * SS * NH + h;
            float s = 0.f;
            for (int t = 0; t < 17; ++t) { const int p = lane * 17 + t; s += (p < PAST) ? cl[(size_t)p * NH] : lf[(size_t)(p - PAST) * NH]; }
            float incl = s;
#pragma unroll
            for (int o = 1; o < 64; o <<= 1) { const float v = __shfl_up(incl, o); if (lane >= o) incl += v; }
            float run = incl - s; float* dst = (float*)(F.ws + WS_CS) + ((size_t)b * NH + h) * SKS + lane * 17;
            for (int t = 0; t < 17; ++t) { const int p = lane * 17 + t; run += (p < PAST) ? cl[(size_t)p * NH] : lf[(size_t)(p - PAST) * NH]; dst[t] = -run * INV_ATT_SCALE; }
        }
    }
}

__device__ __forceinline__ void final_norm(const Args& args, Frame& F) {
    const float* X = (const float*)(F.ws + WS_X); const float* ssq = (const float*)(F.ws + SSQ_OFF) + (size_t)6 * T; const float* gn = IN_(25);
    const int gw = F.vcu * NWAVES + F.wave, NGW = F.G * NWAVES, lane = lane_id_v();
    f32x4 gv[8];
#pragma unroll
    for (int j = 0; j < 8; ++j) gv[j] = *((const f32x4*)gn + lane + 64 * j);
    for (int m = gw; m < T; m += NGW) { const float s = __builtin_amdgcn_rsqf(ssq[m] * (1.0f / DM) + RMS_EPS);
        const f32x4* xr = (const f32x4*)(X + (size_t)m * DM); f32x4* yr = (f32x4*)(F.out + O_YP + (size_t)m * DM);
#pragma unroll
        for (int j = 0; j < 8; ++j) yr[lane + 64 * j] = xr[lane + 64 * j] * s * gv[j]; }
}

__device__ __forceinline__ fox::BlockRef att_ref(int item, int pass) {
    fox::BlockRef r;
    if (item < BP * NH * 8) { const int bh = item >> 3, x = item & 7, qb = pass ? 15 - x : x, b = bh >> 4, h = bh & 15;
        r.qo = (unsigned)((b * SP + qb * 256) * DM + h * HD); r.ko = (unsigned)(b * SP * DM + h * HD); r.co = (unsigned)((b * NH + h) * SP); r.P0 = qb * 256; r.smp = 0; }
    else { const int s = item - BP * NH * 8, b = s >> 4, h = s & 15;
        r.qo = (unsigned)((TP + b * SS) * DM + h * HD); r.ko = (unsigned)(b * SKS * DM + h * HD); r.co = (unsigned)((b * NH + h) * SKS); r.P0 = PAST; r.smp = 1; }
    return r;
}
__device__ __forceinline__ void attn_phase(Frame& F, char* lds) {
    constexpr int NPI = BP * NH * 8, TOTAL = NPI + BS * NH;
    int item = F.vcu; if (item >= TOTAL) return;
    int pass = 0; fox::BlockRef cur = att_ref(item, 0);
    fox::Seam S;
    const int lane = lane_id_v();
    fox::fox_prime(F.ws, cur, lds, S, F.wave);
    for (;;) {
        const bool more_pass = (pass == 0 && item < NPI), more_item = item + F.G < TOTAL, last = !more_pass && !more_item;
        int itn = item, passn = pass + 1;
        if (!more_pass) { passn = 0; itn = more_item ? item + F.G : item; }
        const fox::BlockRef nxt = last ? cur : att_ref(itn, passn);
        fox::fox_block(F.ws, cur, nxt, lds, S, F.wave, lane);
        if (last) break;
        cur = nxt; item = itn; pass = passn;
    }
}

constexpr int NPHASES = 18;
__global__ void __launch_bounds__(NWAVES * 64, 2) fwd(Args args) {
    extern __shared__ __attribute__((aligned(16))) unsigned char lds[];
    Frame F;
    F.lds = (LAS unsigned char*)lds; F.MISC = (volatile LAS unsigned*)(F.lds + MISC_OFF);
    F.wave = __builtin_amdgcn_readfirstlane((int)threadIdx.x >> 6);
    F.G = gridDim.x; { const int bx = blockIdx.x; F.vcu = (F.G % 8 == 0) ? (bx % 8) * (F.G / 8) + bx / 8 : bx; }
    F.ws = args.ws; F.out = args.out;
    unsigned char* ws = args.ws;
    for (int u = threadIdx.x; u < (LDS_BYTES - LDSCTL_OFF) / 4; u += NWAVES * 64) ((LAS unsigned*)(F.lds + LDSCTL_OFF))[u] = 0u;
    __syncthreads();
#if MK_PER_PHASE
#define GRID_BAR() do { } while (0)
#else
    XcdBarrier bar = xcd_barrier_post((unsigned*)(ws + WS_CTL) + CW_BAR, F.MISC + 8);
#define GRID_BAR() xcd_barrier(bar)
#endif
    const int lo = args.ph_lo, hi = args.ph_hi;
#ifndef PH_MASK
#define PH_MASK 0x3ffff
#endif
#define IN(k) (((PH_MASK >> (k)) & 1) && lo <= (k) && (k) < hi)
#define BOTH(k) (IN(k) && IN((k) + 1))
    float* ssq = (float*)(ws + SSQ_OFF);
    float* X = (float*)(ws + WS_X); bf16* XB = (bf16*)(ws + WS_XB); bf16* Hb = (bf16*)(ws + WS_H);
    LAS unsigned char* ring = F.lds + RING_OFF;
    const int bx = (int)blockIdx.x;

#define FFN_G1(f, ssin) do { pg8::Gemm g{XB, (const bf16*)(ws + WS_W1 + (size_t)(f) * SZ_W1), T, 2 * DFF, DM, DM}; pg8::StaticOrder S; S.init(T, 2 * DFF, F.G, bx); \
        pg8::EpiSwiGLU E{Hb, ssq + (size_t)(ssin) * T}; pg8::gemm_phase<pg8::EpiSwiGLU>(ring, g, S, E, F.wave); } while (0)
#define RES_GEMM(Aptr, Wptr, Kdim, xp, xs, ssout, cf) do { pg8::Gemm g{(const bf16*)(Aptr), (const bf16*)(Wptr), T, DM, (Kdim), (Kdim)}; pg8::StaticOrder S; S.init(T, DM, F.G, bx); \
        pg8::EpiRes E{(xp), (xs), X, XB, ssq + (size_t)(ssout) * T, (cf)}; pg8::gemm_phase<pg8::EpiRes>(ring, g, S, E, F.wave); } while (0)

    if (IN(0)) { p0_prologue(args, F); if (BOTH(0)) GRID_BAR(); }
    if (IN(1)) { FFN_G1(0, 0); if (BOTH(1)) GRID_BAR(); }
    if (IN(2)) { RES_GEMM(Hb, ws + WS_W2, DFF, args.in[0], args.in[1], 1, 0.5f); if (BOTH(2)) GRID_BAR(); }
    if (IN(3)) { pg8::Gemm g{XB, (const bf16*)(ws + WS_WAIN), T, 2 * DR, DM, DM}; pg8::StaticOrder S; S.init(T, 2 * DR, F.G, bx);
        pg8::EpiAin E{(bf16*)(ws + WS_GG), (bf16*)(ws + WS_U), ssq + (size_t)1 * T}; pg8::gemm_phase<pg8::EpiAin>(ring, g, S, E, F.wave); if (BOTH(3)) GRID_BAR(); }
    if (IN(4)) { conv_phase(args, F); if (BOTH(4)) GRID_BAR(); }
    if (IN(5)) { pg8::Gemm g{(const bf16*)(ws + WS_UC), (const bf16*)(ws + WS_WG), T, 2 * DR, 256, DR}; pg8::StaticOrder S; S.init(T, 2 * DR, F.G, bx);
        pg8::EpiGates E{(const bf16*)(ws + WS_UC), (bf16*)(ws + WS_LA), (bf16*)(ws + WS_INP), args.in[15], (const float*)(ws + WS_CL)}; pg8::gemm_phase<pg8::EpiGates>(ring, g, S, E, F.wave); if (BOTH(5)) GRID_BAR(); }
    if (IN(6)) { scan_phase(args, F); if (BOTH(6)) GRID_BAR(); }
    if (IN(7)) { RES_GEMM(ws + WS_GG, ws + WS_WAOUT, DR, X, X + (size_t)TP * DM, 2, 1.0f); if (BOTH(7)) GRID_BAR(); }
    if (IN(8)) { FFN_G1(1, 2); if (BOTH(8)) GRID_BAR(); }
    if (IN(9)) { RES_GEMM(Hb, ws + WS_W2 + SZ_W2, DFF, X, X + (size_t)TP * DM, 3, 0.5f); if (BOTH(9)) GRID_BAR(); }
    if (IN(10)) {
        { pg8::Gemm g{XB, (const bf16*)(ws + WS_WKV), T, 2 * DM + 256, DM, DM}; pg8::StaticOrder S; S.init(T, 2 * DM + 256, F.G, bx);
          pg8::EpiKV E{F.out, ws, ssq + (size_t)3 * T, args.in[21]};
          pg8::gemm_phase<pg8::EpiKV>(ring, g, S, E, F.wave); }
        FFN_G1(2, 3);
        if (BOTH(10)) GRID_BAR(); }
    if (IN(11)) { RES_GEMM(Hb, ws + WS_W2 + 2 * SZ_W2, DFF, X, X + (size_t)TP * DM, 4, 0.5f); cumsum_items(args, F); if (BOTH(11)) GRID_BAR(); }
    if (IN(12)) { pg8::Gemm g{XB, (const bf16*)(ws + WS_WQG), T, 2 * DM, DM, DM}; pg8::StaticOrder S; S.init(T, 2 * DM, F.G, bx);
        pg8::EpiQG E{(bf16*)(ws + WS_Q), (bf16*)(ws + WS_SG), ssq + (size_t)4 * T}; pg8::gemm_phase<pg8::EpiQG>(ring, g, S, E, F.wave); if (BOTH(12)) GRID_BAR(); }
    if (IN(13)) { attn_phase(F, (char*)lds + RING_OFF); if (BOTH(13)) GRID_BAR(); }
    if (IN(14)) { RES_GEMM(ws + WS_Q, ws + WS_WO, DM, X, X + (size_t)TP * DM, 5, 1.0f); if (BOTH(14)) GRID_BAR(); }
    if (IN(15)) { FFN_G1(3, 5); if (BOTH(15)) GRID_BAR(); }
    if (IN(16)) { RES_GEMM(Hb, ws + WS_W2 + 3 * SZ_W2, DFF, X, X + (size_t)TP * DM, 6, 0.5f); if (BOTH(16)) GRID_BAR(); }
    if (IN(17)) { final_norm(args, F); }
#undef IN
#undef BOTH
}

extern "C" void kernel_launch(void* const* d_in, const int* in_sizes, int n_in, void* d_out, int out_size, void* d_ws, size_t ws_size, hipStream_t stream) {
    static int grid = 0;
    if (grid == 0) {
        if (n_in != 26 || in_sizes[0] != TP * DM || (size_t)out_size != O_END || ws_size < WS_END) {
            fprintf(stderr, "kernel_launch: shape mismatch (n_in %d, in0 %d, out %d (want %zu), ws %zu (want %zu)); nothing launched\n", n_in, n_in > 0 ? in_sizes[0] : -1, out_size, (size_t)O_END, ws_size, (size_t)WS_END); grid = -1; return; }
        int dev = 0, cus = 0, per_cu = 0;
        if (hipGetDevice(&dev) != hipSuccess || hipDeviceGetAttribute(&cus, hipDeviceAttributeMultiprocessorCount, dev) != hipSuccess) { fprintf(stderr, "kernel_launch: device query failed\n"); grid = -1; return; }
        if (hipFuncSetAttribute((const void*)fwd, hipFuncAttributeMaxDynamicSharedMemorySize, LDS_BYTES) != hipSuccess) { fprintf(stderr, "kernel_launch: hipFuncSetAttribute failed\n"); grid = -1; return; }
        if (hipOccupancyMaxActiveBlocksPerMultiprocessor(&per_cu, (const void*)fwd, NWAVES * 64, LDS_BYTES) != hipSuccess || per_cu < 1)
            fprintf(stderr, "kernel_launch: note: occupancy query reports %d workgroups per CU\n", per_cu);
        (void)hipGetLastError();
        grid = cus;
    }
    if (grid < 0) return;
    if (hipMemsetAsync((char*)d_ws + WS_CTL, 0, CTL_ZERO_BYTES, stream) != hipSuccess) { fprintf(stderr, "kernel_launch: memset failed\n"); return; }
    Args a{};
    for (int i = 0; i < 26; ++i) a.in[i] = (const float*)d_in[i];
    a.out = (float*)d_out; a.ws = (unsigned char*)d_ws;
#if MK_PER_PHASE
    for (int p = 0; p < NPHASES; ++p) { a.ph_lo = p; a.ph_hi = p + 1; hipLaunchKernelGGL(fwd, dim3(grid), dim3(NWAVES * 64), LDS_BYTES, stream, a); }
#else
    a.ph_lo = 0; a.ph_hi = NPHASES;
    hipLaunchKernelGGL(fwd, dim3(grid), dim3(NWAVES * 64), LDS_BYTES, stream, a);
#endif
    const hipError_t le = hipPeekAtLastError();
    if (le != hipSuccess) fprintf(stderr, "kernel_launch: launch failed: %s\n", hipGetErrorName(le));
}
```

```cpp
#include <hip/hip_runtime.h>
#include <hip/hip_bf16.h>
#include <cstdio>
#include <cstdint>

#ifndef PROBE_MASK
#define PROBE_MASK 0
#endif
#ifndef MK_PER_PHASE
#define MK_PER_PHASE 0
#endif

constexpr int DM = 2048, BP = 4, SP = 4096, BS = 16, SS = 64, PAST = 1024;
constexpr int TP = BP * SP, TS = BS * SS, T = TP + TS;
constexpr int DFF = 5632, DR = 2560, NH = 16, HD = 128, NRH = 10;
constexpr int SKS = PAST + SS;
constexpr float RMS_EPS = 1e-6f;
constexpr float ATT_SCALE = 0.08838834764831845f;
constexpr float INV_ATT_SCALE = 11.313708498984761f;

#define GAS __attribute__((address_space(1)))
#define LAS __attribute__((address_space(3)))
typedef unsigned short bf16;
typedef unsigned v4u __attribute__((ext_vector_type(4)));
typedef unsigned v2u __attribute__((ext_vector_type(2)));
typedef float f32x4 __attribute__((ext_vector_type(4)));
typedef float f32x2 __attribute__((ext_vector_type(2)));
typedef float f32x16 __attribute__((ext_vector_type(16)));
typedef short bf16x8 __attribute__((ext_vector_type(8)));
typedef short s16x4 __attribute__((ext_vector_type(4)));
typedef GAS unsigned gu32;

__device__ __forceinline__ unsigned cvt_pk_bf16(float lo, float hi) { unsigned r; asm volatile("v_cvt_pk_bf16_f32 %0, %1, %2" : "=v"(r) : "v"(lo), "v"(hi)); return r; }
__device__ __forceinline__ float bf_lo(unsigned w) { return __uint_as_float(w << 16); }
__device__ __forceinline__ float bf_hi(unsigned w) { return __uint_as_float(w & 0xffff0000u); }
__device__ __forceinline__ int lane_id_v() { int l; asm volatile("v_mbcnt_lo_u32_b32 %0, -1, 0\n\tv_mbcnt_hi_u32_b32 %0, -1, %0" : "=v"(l)); return l; }
__device__ __forceinline__ float fast_sigmoid(float x) { return __builtin_amdgcn_rcpf(1.0f + __builtin_amdgcn_exp2f(-1.4426950408889634f * x)); }

constexpr int NWAVES = 8;
constexpr size_t al4k(size_t x) { return (x + 4095) & ~(size_t)4095; }
constexpr size_t WS_CTL = 0, CTL_ZERO_BYTES = 1u << 20;
constexpr int CW_BAR = 4096;
constexpr size_t SSQ_OFF = 262144;
constexpr int NSSQ = 7;
static_assert(SSQ_OFF + (size_t)NSSQ * T * 4 <= CTL_ZERO_BYTES, "ssq inside the memset region");
constexpr size_t SZ_W1 = (size_t)2 * DFF * DM * 2, SZ_W2 = (size_t)DM * DFF * 2;
constexpr size_t WS_W1 = CTL_ZERO_BYTES;
constexpr size_t WS_W2 = WS_W1 + 4 * SZ_W1;
constexpr size_t WS_WAIN = WS_W2 + 4 * SZ_W2;
constexpr size_t WS_WG = WS_WAIN + (size_t)2 * DR * DM * 2;
constexpr size_t WS_WAOUT = WS_WG + (size_t)2 * DR * 256 * 2;
constexpr size_t WS_WKV = WS_WAOUT + (size_t)DM * DR * 2;
constexpr size_t WS_WQG = WS_WKV + (size_t)(2 * DM + 256) * DM * 2;
constexpr size_t WS_WO = WS_WQG + (size_t)2 * DM * DM * 2;
constexpr size_t WS_CL = WS_WO + (size_t)DM * DM * 2;
constexpr size_t WS_X = al4k(WS_CL + DR * 4);
constexpr size_t WS_XB = WS_X + (size_t)T * DM * 4;
constexpr size_t WS_KMX = WS_X;
constexpr size_t WS_H = WS_XB + (size_t)T * DM * 2;
constexpr size_t SZ_R = (size_t)T * DR * 2, SZ_D = (size_t)T * DM * 2;
constexpr size_t WS_U = WS_H, WS_UC = WS_H + SZ_R;
constexpr size_t WS_LA = WS_U;
constexpr size_t WS_Q = WS_H, WS_SG = WS_H + SZ_D;
constexpr size_t WS_GG = WS_H + (size_t)T * DFF * 2;
constexpr size_t WS_INP = WS_GG + SZ_R;
constexpr size_t WS_KP = WS_INP + SZ_R, WS_VP = WS_KP + (size_t)TP * DM * 2;
constexpr size_t WS_KS = WS_VP + (size_t)TP * DM * 2, WS_VS = WS_KS + (size_t)TS * DM * 2;
constexpr size_t WS_CP = WS_VS + (size_t)TS * DM * 2;
constexpr size_t WS_CS = WS_CP + (size_t)BP * NH * SP * 4;
constexpr size_t WS_END = WS_CS + (size_t)BS * NH * SKS * 4;
static_assert(2 * SZ_R <= (size_t)T * DFF * 2 && 2 * SZ_D <= (size_t)T * DFF * 2, "overlays fit in H");
constexpr size_t O_YP = 0, O_YS = O_YP + (size_t)TP * DM, O_CONVP = O_YS + (size_t)TS * DM, O_HP = O_CONVP + (size_t)BP * 3 * DR, O_KP = O_HP + (size_t)BP * DR,
                 O_VP = O_KP + (size_t)TP * DM, O_LFP = O_VP + (size_t)TP * DM, O_CONVS = O_LFP + (size_t)TP * NH, O_HS = O_CONVS + (size_t)BS * 3 * DR,
                 O_KS = O_HS + (size_t)BS * DR, O_VS = O_KS + (size_t)TS * DM, O_LFS = O_VS + (size_t)TS * DM, O_END = O_LFS + (size_t)TS * NH;

#ifndef PG8_ALIGN_EPI
#define PG8_ALIGN_EPI 1
#endif
namespace pg8 {
#define PG8_LAS __attribute__((address_space(3)))
typedef unsigned short bf16_t;
constexpr int BM = 256, BK = 64, HALF = 128, HTB = HALF * BK * 2, STAGE_BYTES = 8 * HTB, NXCD = 8, WGM = 8;

__host__ __device__ __forceinline__ int lds_byte(int r, int c) { const int st = (r >> 4) * 2 + (c >> 5), rr = r & 15, cc = c & 31, ob = rr * 64 + cc * 2; return st * 1024 + (ob ^ (((ob >> 9) & 1) << 5)); }
__host__ __device__ __forceinline__ void stage_rc(int b, int& R, int& C) { const int st = b / 1024, sb = b % 1024, swz = sb ^ (((sb >> 9) & 1) << 5); R = (st >> 1) * 16 + swz / 64; C = (st & 1) * 32 + (swz % 64) / 2; }
__host__ __device__ __forceinline__ int perm32(int rho) { const int n = rho >> 4, i = rho & 15; return 8 * (i >> 2) + 4 * n + (i & 3); }

struct Unit { int pm, pn, kt0, nkt, split; };
struct Gemm { const bf16_t* A; const bf16_t* Bt; int M, N, K, lda; };

struct StaticOrder {
    int nM, nN, nwg, G, c, nkt;
    __device__ __forceinline__ void init(int M, int N, int K, int G_, int c_) { nM = M / BM; nN = N / BM; nwg = nM * nN; G = G_; c = c_; nkt = K / BK; }
    __device__ __forceinline__ bool next(int i, Unit& u) const {
        const long L = (long)i * G + c; if (L >= nwg) return false;
        int wgid = (int)L; { const int q = nwg / NXCD, r = nwg % NXCD, xcd = wgid % NXCD, off = wgid / NXCD; wgid = (xcd < r ? xcd * (q + 1) : r * (q + 1) + (xcd - r) * q) + off; }
        const int nig = WGM * nN, gid = wgid / nig, fm = gid * WGM, gsz = (nM - fm) < WGM ? (nM - fm) : WGM;
        u.pm = fm + ((wgid % nig) % gsz); u.pn = (wgid % nig) / gsz; u.kt0 = 0; u.nkt = nkt; u.split = -1; return true;
    }
};
struct ResOrder {
    int nkt, G, c;
    __device__ __forceinline__ void init(int K, int G_, int c_) { nkt = K / BK; G = G_; c = c_; }
    __device__ __forceinline__ bool next(int i, Unit& u) const {
        constexpr int nM = TP / BM, nN = DM / BM, nwg = nM * nN;
        const int L = i * G + c;
        if (L >= nwg + 32 * 8) return false;
        int pm, pn, kt0 = 0, nk = nkt, sp = -1;
        if (L < nwg) {
            const int xcd = L % NXCD, off = L / NXCD, rnd = off >> 5, j = off & 31;
            pm = 8 * xcd + 4 * rnd + (j & 3); pn = j >> 2;
        } else {
            const int s = L - nwg, tile = s & 31; sp = s >> 5; pm = nM + (tile >> 3); pn = tile & 7;
            kt0 = 2 * ((sp * nkt) >> 4); nk = 2 * (((sp + 1) * nkt) >> 4) - kt0;
        }
        u.pm = pm; u.pn = pn; u.kt0 = kt0; u.nkt = nk; u.split = sp; return true;
    }
};

template <class Epi, class Sched>
__device__ __forceinline__ void gemm_phase(PG8_LAS unsigned char* lds, const Gemm g, const Sched& S, const Epi& E, const int wid) {
    const int lane = lane_id_v(), tid = wid * 64 + lane, wr = wid >> 2, wc = wid & 3, fr = lane & 15, fq = lane >> 4;
    const int K = g.K, lda = g.lda;
    unsigned voffA[2], voffB[2];
#pragma unroll
    for (int i = 0; i < 2; ++i) { int R, C; stage_rc(tid * 16 + i * 8192, R, C); const int Rb = Epi::PERM ? ((R & ~31) + perm32(R & 31)) : R;
        voffA[i] = (unsigned)(R * lda + C) * 2u; voffB[i] = (unsigned)(Rb * K + C) * 2u; }
    const size_t kstep = (size_t)(BK * 2);
    const size_t hstepA = (size_t)HALF * lda * 2, hstepB = (size_t)HALF * K * 2;
    const size_t tstepA = 2 * hstepA, tstepB = 2 * hstepB;
    const unsigned ldsw = (unsigned)wid * 1024u;
    const int aoff = lds_byte(wr * 64 + fr, fq * 8), boff = lds_byte(wc * 32 + fr, fq * 8);
#define PG8_SA(b, h) (((b) * 2 + (h)) * HTB)
#define PG8_SB(b, h) ((4 + (b) * 2 + (h)) * HTB)
#define PG8_STAGE(bufoff, gbase, voff) do { _Pragma("unroll") for (int _i = 0; _i < 2; ++_i) \
        __builtin_amdgcn_global_load_lds((const unsigned*)((const char*)(gbase) + (voff)[_i]), (PG8_LAS unsigned*)(lds + (bufoff) + ldsw + _i * 8192), 16, 0, 0); } while (0)
#define PG8_LDA(dst, b, h) do { _Pragma("unroll") for (int m = 0; m < 4; ++m) _Pragma("unroll") for (int k = 0; k < 2; ++k) dst[m][k] = *(const PG8_LAS bf16x8*)(lds + PG8_SA(b, h) + aoff + m * 2048 + k * 1024); } while (0)
#define PG8_LDB(dst, b, h) do { _Pragma("unroll") for (int n = 0; n < 2; ++n) _Pragma("unroll") for (int k = 0; k < 2; ++k) dst[n][k] = *(const PG8_LAS bf16x8*)(lds + PG8_SB(b, h) + boff + n * 2048 + k * 1024); } while (0)
#define PG8_MMA(ai, bj, At, Bt) do { __builtin_amdgcn_s_setprio(1); _Pragma("unroll") for (int m = 0; m < 4; ++m) _Pragma("unroll") for (int n = 0; n < 2; ++n) _Pragma("unroll") for (int k = 0; k < 2; ++k) \
        acc[ai][bj][m][n] = __builtin_amdgcn_mfma_f32_16x16x32_bf16(Bt[n][k], At[m][k], acc[ai][bj][m][n], 0, 0, 0); __builtin_amdgcn_s_setprio(0); } while (0)
#define PG8_WAIT_V(n) asm volatile("s_waitcnt vmcnt(" #n ")" ::: "memory")
#define PG8_WAIT_L(n) asm volatile("s_waitcnt lgkmcnt(" #n ")" ::: "memory")
#define PG8_BAR __builtin_amdgcn_s_barrier()
#define PG8_SCHED __builtin_amdgcn_sched_barrier(0)
    Unit cur, nxt; int ui = 0;
    if (!S.next(0, cur)) return;
    f32x4 acc[2][2][4][2];
#pragma unroll
    for (int a = 0; a < 2; ++a)
#pragma unroll
        for (int b = 0; b < 2; ++b)
#pragma unroll
            for (int m = 0; m < 4; ++m)
#pragma unroll
                for (int n = 0; n < 2; ++n) acc[a][b][m][n] = (f32x4){0.f, 0.f, 0.f, 0.f};
    bf16x8 At[4][2], B0[2][2], B1[2][2];
    const char* cA = (const char*)g.A + (size_t)cur.pm * tstepA + (size_t)Epi::acol(cur) * 2 + (size_t)cur.kt0 * kstep; const char* cB = (const char*)g.Bt + (size_t)cur.pn * tstepB + (size_t)cur.kt0 * kstep;
    PG8_STAGE(PG8_SB(0, 0), cB, voffB); PG8_STAGE(PG8_SB(0, 1), cB + hstepB, voffB); PG8_STAGE(PG8_SA(0, 0), cA, voffA); PG8_STAGE(PG8_SA(0, 1), cA + hstepA, voffA);
    if (wr == 1) PG8_BAR;
    PG8_WAIT_V(2); PG8_BAR;
    PG8_STAGE(PG8_SB(1, 0), cB + kstep, voffB); PG8_STAGE(PG8_SA(1, 0), cA + kstep, voffA); PG8_STAGE(PG8_SB(1, 1), cB + hstepB + kstep, voffB);
    PG8_WAIT_V(6); PG8_BAR;
    for (;;) {
        const bool has_next = S.next(ui + 1, nxt);
        const char* nA = has_next ? (const char*)g.A + (size_t)nxt.pm * tstepA + (size_t)Epi::acol(nxt) * 2 + (size_t)nxt.kt0 * kstep : cA; const char* nB = has_next ? (const char*)g.Bt + (size_t)nxt.pn * tstepB + (size_t)nxt.kt0 * kstep : cB;
        const int nt = cur.nkt;
        for (int t = 0; t < nt; t += 2) {
            const bool last = (t == nt - 2);
            const char* a1 = cA + (size_t)(t + 1) * kstep;
            const char* a2 = last ? nA : cA + (size_t)(t + 2) * kstep; const char* b2 = last ? nB : cB + (size_t)(t + 2) * kstep;
            const char* a3 = a2 + kstep; const char* b3 = b2 + kstep;
            PG8_LDB(B0, 0, 0); PG8_LDB(B1, 0, 1); PG8_SCHED; PG8_LDA(At, 0, 0); PG8_STAGE(PG8_SA(1, 1), a1 + hstepA, voffA);
            PG8_WAIT_V(8); PG8_WAIT_L(0); PG8_BAR; PG8_MMA(0, 0, At, B0); PG8_MMA(0, 1, At, B1); PG8_BAR; PG8_SCHED;
            PG8_LDA(At, 0, 1); PG8_STAGE(PG8_SB(0, 0), b2, voffB); PG8_STAGE(PG8_SB(0, 1), b2 + hstepB, voffB); PG8_STAGE(PG8_SA(0, 0), a2, voffA);
            PG8_WAIT_V(8); PG8_WAIT_L(0); PG8_BAR; PG8_MMA(1, 0, At, B0); PG8_MMA(1, 1, At, B1); PG8_BAR; PG8_SCHED;
            PG8_LDB(B0, 1, 0); PG8_LDB(B1, 1, 1); PG8_SCHED; PG8_LDA(At, 1, 0); PG8_STAGE(PG8_SA(0, 1), a2 + hstepA, voffA);
            PG8_WAIT_V(8); PG8_WAIT_L(0); PG8_BAR; PG8_MMA(0, 0, At, B0); PG8_MMA(0, 1, At, B1); PG8_BAR; PG8_SCHED;
            PG8_LDA(At, 1, 1); PG8_STAGE(PG8_SB(1, 0), b3, voffB); PG8_STAGE(PG8_SB(1, 1), b3 + hstepB, voffB); PG8_STAGE(PG8_SA(1, 0), a3, voffA);
            PG8_WAIT_V(8); PG8_WAIT_L(0); PG8_BAR; PG8_MMA(1, 0, At, B0); PG8_MMA(1, 1, At, B1); PG8_BAR; PG8_SCHED;
        }
        if (PG8_ALIGN_EPI) { if (wr == 0) PG8_BAR; }
        E(acc, cur, wr, wc, fr, fq);
        if (!has_next) break;
#pragma unroll
        for (int a = 0; a < 2; ++a)
#pragma unroll
            for (int b = 0; b < 2; ++b)
#pragma unroll
                for (int m = 0; m < 4; ++m)
#pragma unroll
                    for (int n = 0; n < 2; ++n) acc[a][b][m][n] = (f32x4){0.f, 0.f, 0.f, 0.f};
        cur = nxt; cA = nA; cB = nB; ++ui;
        if (PG8_ALIGN_EPI) { if (wr == 1) PG8_BAR; }
    }
    PG8_WAIT_V(0);
    if (!PG8_ALIGN_EPI) { if (wr == 0) PG8_BAR; }
    PG8_BAR;
#undef PG8_SA
#undef PG8_SB
#undef PG8_STAGE
#undef PG8_LDA
#undef PG8_LDB
#undef PG8_MMA
#undef PG8_WAIT_V
#undef PG8_WAIT_L
#undef PG8_BAR
#undef PG8_SCHED
}

__device__ __forceinline__ void row_scales(const float* ss, int row0, float (&sv)[8]) {
#pragma unroll
    for (int i = 0; i < 8; ++i) sv[i] = ss[row0 + (i >> 2) * HALF + (i & 3) * 16];
#pragma unroll
    for (int i = 0; i < 8; ++i) sv[i] = __builtin_amdgcn_rsqf(sv[i] * (1.0f / DM) + RMS_EPS);
}

__device__ __forceinline__ f32x2 exp2_pk(f32x2 t) { f32x2 e; e.x = __builtin_amdgcn_exp2f(t.x); e.y = __builtin_amdgcn_exp2f(t.y); return e; }
__device__ __forceinline__ f32x2 rcp_pk(f32x2 d) { f32x2 r; r.x = __builtin_amdgcn_rcpf(d.x); r.y = __builtin_amdgcn_rcpf(d.y); return r; }
__device__ __forceinline__ f32x2 sigmoid_scaled_pk(f32x2 a, float kL) { return rcp_pk(exp2_pk(a * kL) + 1.0f); }
__device__ __forceinline__ f32x2 gelu_tanh_pk(f32x2 a, float s) {
    const f32x2 x = a * s, x2 = x * x;
    const f32x2 p = x2 * (-1.4426950408889634f * 1.5957691216057308f * 0.044715f) + (-1.4426950408889634f * 1.5957691216057308f);
    return x * rcp_pk(exp2_pk(x * p) + 1.0f);
}
__device__ __forceinline__ f32x2 silu_mul_pk(f32x2 g, f32x2 u, float sL, float s2) {
    const f32x2 t = g * sL; f32x2 e; e.x = __builtin_amdgcn_exp2f(t.x); e.y = __builtin_amdgcn_exp2f(t.y);
    const f32x2 d = e + 1.0f; f32x2 r; r.x = __builtin_amdgcn_rcpf(d.x); r.y = __builtin_amdgcn_rcpf(d.y);
    return (g * u) * (r * s2);
}
struct EpiSwiGLU {
    static constexpr bool PERM = true;
    static __device__ __forceinline__ int acol(const Unit&) { return 0; }
    bf16_t* H; const float* ss;
    __device__ __forceinline__ void operator()(const f32x4 (&acc)[2][2][4][2], const Unit& u, int wr, int wc, int fr, int fq) const {
        const int row0 = u.pm * BM + wr * 64 + fr, col0 = u.pn * 128 + wc * 32 + 8 * fq;
        float sv[8]; row_scales(ss, row0, sv);
#pragma unroll
        for (int ai = 0; ai < 2; ++ai)
#pragma unroll
            for (int m = 0; m < 4; ++m) { const int row = row0 + ai * HALF + m * 16; const float s = sv[ai * 4 + m], sL = s * -1.4426950408889634f, s2 = s * s;
                f32x2 o[4];
#pragma unroll
                for (int n = 0; n < 2; ++n) { const f32x4 g4 = acc[ai][0][m][n], u4 = acc[ai][1][m][n];
                    o[2 * n] = silu_mul_pk((f32x2){g4[0], g4[1]}, (f32x2){u4[0], u4[1]}, sL, s2); o[2 * n + 1] = silu_mul_pk((f32x2){g4[2], g4[3]}, (f32x2){u4[2], u4[3]}, sL, s2); }
                v4u w; w.x = cvt_pk_bf16(o[0].x, o[0].y); w.y = cvt_pk_bf16(o[1].x, o[1].y); w.z = cvt_pk_bf16(o[2].x, o[2].y); w.w = cvt_pk_bf16(o[3].x, o[3].y);
                __builtin_nontemporal_store(w, (v4u*)(H + (size_t)row * DFF + col0)); }
    }
};

struct EpiRes {
    static constexpr bool PERM = true;
    static __device__ __forceinline__ int acol(const Unit&) { return 0; }
    const float* xin_p; const float* xin_s; bf16_t* XB; float* ssq; float coef; float* slab; int first;
    __device__ __forceinline__ void operator()(const f32x4 (&acc)[2][2][4][2], const Unit& u, int wr, int wc, int fr, int fq) const {
        if (u.split >= 0) {
            bf16_t* sl = (bf16_t*)slab + ((size_t)(((u.pm - TP / BM) * 8 + u.pn) * 8 + u.split) << 16) + (size_t)(wr * 64 + fr) * BM + wc * 32 + 8 * fq;
#pragma unroll
            for (int ai = 0; ai < 2; ++ai)
#pragma unroll
                for (int m = 0; m < 4; ++m)
#pragma unroll
                    for (int bj = 0; bj < 2; ++bj) { const f32x4 a = acc[ai][bj][m][0], b = acc[ai][bj][m][1];
                        v4u o; o.x = cvt_pk_bf16(a[0], a[1]); o.y = cvt_pk_bf16(a[2], a[3]); o.z = cvt_pk_bf16(b[0], b[1]); o.w = cvt_pk_bf16(b[2], b[3]);
                        *(v4u*)(sl + (size_t)(ai * HALF + m * 16) * BM + bj * HALF) = o; }
            return; }
        const int row0 = u.pm * BM + wr * 64 + fr, col0 = u.pn * BM + wc * 32 + 8 * fq;
        const float* xin = (u.pm < TP / BM) ? xin_p : (xin_s - (size_t)TP * DM);
        if (first) {
#pragma unroll
            for (int ai = 0; ai < 2; ++ai) { float rs[4];
#pragma unroll
                for (int mp = 0; mp < 4; mp += 2) { f32x4 xl[2][2][2];
#pragma unroll
                    for (int mm = 0; mm < 2; ++mm)
#pragma unroll
                        for (int bj = 0; bj < 2; ++bj) { const size_t off = (size_t)(row0 + ai * HALF + (mp + mm) * 16) * DM + col0 + bj * HALF; xl[mm][bj][0] = *(const f32x4*)(xin + off); xl[mm][bj][1] = *(const f32x4*)(xin + off + 4); }
#pragma unroll
                    for (int mm = 0; mm < 2; ++mm) { const int m = mp + mm; const size_t off = (size_t)(row0 + ai * HALF + m * 16) * DM + col0; float q = 0.f;
#pragma unroll
                        for (int bj = 0; bj < 2; ++bj) { float xn[8];
#pragma unroll
                            for (int e = 0; e < 8; ++e) { xn[e] = xl[mm][bj][e >> 2][e & 3] + acc[ai][bj][m][e >> 2][e & 3] * coef; q += xn[e] * xn[e]; }
                            v4u o; o.x = cvt_pk_bf16(xn[0], xn[1]); o.y = cvt_pk_bf16(xn[2], xn[3]); o.z = cvt_pk_bf16(xn[4], xn[5]); o.w = cvt_pk_bf16(xn[6], xn[7]);
                            *(v4u*)(XB + off + bj * HALF) = o; }
                        q += __shfl_xor(q, 16); q += __shfl_xor(q, 32); rs[m] = q; } }
                { const float v = fq == 0 ? rs[0] : (fq == 1 ? rs[1] : (fq == 2 ? rs[2] : rs[3])); __hip_atomic_fetch_add(ssq + row0 + ai * HALF + fq * 16, v, __ATOMIC_RELAXED, __HIP_MEMORY_SCOPE_AGENT); } }
        } else {
            v4u xw[2][4][2];
#pragma unroll
            for (int ai = 0; ai < 2; ++ai)
#pragma unroll
                for (int m = 0; m < 4; ++m)
#pragma unroll
                    for (int bj = 0; bj < 2; ++bj) xw[ai][m][bj] = *(const v4u*)(XB + (size_t)(row0 + ai * HALF + m * 16) * DM + col0 + bj * HALF);
#pragma unroll
            for (int ai = 0; ai < 2; ++ai) { float rs[4];
#pragma unroll
                for (int m = 0; m < 4; ++m) { const size_t off = (size_t)(row0 + ai * HALF + m * 16) * DM + col0; float q = 0.f;
                    f32x2 q2 = {0.f, 0.f};
#pragma unroll
                    for (int bj = 0; bj < 2; ++bj) { const v4u w = xw[ai][m][bj]; const f32x4 a0 = acc[ai][bj][m][0], a1 = acc[ai][bj][m][1];
                        const f32x2 x0 = (f32x2){bf_lo(w.x), bf_hi(w.x)} + (f32x2){a0[0], a0[1]} * coef, x1 = (f32x2){bf_lo(w.y), bf_hi(w.y)} + (f32x2){a0[2], a0[3]} * coef;
                        const f32x2 x2 = (f32x2){bf_lo(w.z), bf_hi(w.z)} + (f32x2){a1[0], a1[1]} * coef, x3 = (f32x2){bf_lo(w.w), bf_hi(w.w)} + (f32x2){a1[2], a1[3]} * coef;
                        q2 += x0 * x0; q2 += x1 * x1; q2 += x2 * x2; q2 += x3 * x3;
                        v4u o; o.x = cvt_pk_bf16(x0.x, x0.y); o.y = cvt_pk_bf16(x1.x, x1.y); o.z = cvt_pk_bf16(x2.x, x2.y); o.w = cvt_pk_bf16(x3.x, x3.y);
                        *(v4u*)(XB + off + bj * HALF) = o; }
                    q = q2.x + q2.y;
                    q += __shfl_xor(q, 16); q += __shfl_xor(q, 32); rs[m] = q; }
                { const float v = fq == 0 ? rs[0] : (fq == 1 ? rs[1] : (fq == 2 ? rs[2] : rs[3])); __hip_atomic_fetch_add(ssq + row0 + ai * HALF + fq * 16, v, __ATOMIC_RELAXED, __HIP_MEMORY_SCOPE_AGENT); } }
        }
    }
};

struct EpiAin {
    static constexpr bool PERM = true;
    static __device__ __forceinline__ int acol(const Unit&) { return 0; }
    bf16_t* GG; bf16_t* U; const float* ss;
    __device__ __forceinline__ void operator()(const f32x4 (&acc)[2][2][4][2], const Unit& u, int wr, int wc, int fr, int fq) const {
        const bool isu = u.pn >= 10; const int row0 = u.pm * BM + wr * 64 + fr, col0 = (isu ? u.pn - 10 : u.pn) * BM + wc * 32 + 8 * fq; bf16_t* dst = isu ? U : GG;
        float sv[8]; row_scales(ss, row0, sv);
#pragma unroll
        for (int ai = 0; ai < 2; ++ai)
#pragma unroll
            for (int m = 0; m < 4; ++m) { const int row = row0 + ai * HALF + m * 16; const float s = sv[ai * 4 + m];
#pragma unroll
                for (int bj = 0; bj < 2; ++bj) { f32x2 o[4];
#pragma unroll
                    for (int n = 0; n < 2; ++n) { const f32x4 a4 = acc[ai][bj][m][n]; const f32x2 a0 = {a4[0], a4[1]}, a1 = {a4[2], a4[3]};
                        if (isu) { o[2 * n] = a0 * s; o[2 * n + 1] = a1 * s; } else { o[2 * n] = gelu_tanh_pk(a0, s); o[2 * n + 1] = gelu_tanh_pk(a1, s); } }
                    v4u w; w.x = cvt_pk_bf16(o[0].x, o[0].y); w.y = cvt_pk_bf16(o[1].x, o[1].y); w.z = cvt_pk_bf16(o[2].x, o[2].y); w.w = cvt_pk_bf16(o[3].x, o[3].y);
                    *(v4u*)(dst + (size_t)row * DR + col0 + bj * HALF) = w; } }
    }
};

struct EpiGates {
    static constexpr bool PERM = true;
    static __device__ __forceinline__ int acol(const Unit& u) { return (u.pn >> 1) * 256; }
    const bf16_t* UC; bf16_t* LA; bf16_t* INP; const float* gb; const float* cl;
    __device__ __forceinline__ void operator()(const f32x4 (&acc)[2][2][4][2], const Unit& u, int wr, int wc, int fr, int fq) const {
        const int row0 = u.pm * BM + wr * 64 + fr, ch0 = (u.pn >> 1) * 256 + (u.pn & 1) * 128 + wc * 32 + 8 * fq;
        constexpr float NL2E = -1.4426950408889634f;
        f32x2 brL[4], biL[4], cv2[4];
#pragma unroll
        for (int n = 0; n < 2; ++n) { const f32x4 a = *(const f32x4*)(gb + ch0 + 4 * n), b = *(const f32x4*)(gb + DR + ch0 + 4 * n), c = *(const f32x4*)(cl + ch0 + 4 * n);
            brL[2 * n] = (f32x2){a[0], a[1]} * NL2E; brL[2 * n + 1] = (f32x2){a[2], a[3]} * NL2E; biL[2 * n] = (f32x2){b[0], b[1]} * NL2E; biL[2 * n + 1] = (f32x2){b[2], b[3]} * NL2E;
            cv2[2 * n] = (f32x2){c[0], c[1]}; cv2[2 * n + 1] = (f32x2){c[2], c[3]}; }
        v4u ucl[8];
#pragma unroll
        for (int i = 0; i < 8; ++i) ucl[i] = *(const v4u*)(UC + (size_t)(row0 + (i >> 2) * HALF + (i & 3) * 16) * DR + ch0);
#pragma unroll
        for (int ai = 0; ai < 2; ++ai)
#pragma unroll
            for (int m = 0; m < 4; ++m) { const int row = row0 + ai * HALF + m * 16; const size_t off = (size_t)row * DR + ch0;
                const v4u ucw = ucl[ai * 4 + m];
                const f32x2 uc[4] = {(f32x2){bf_lo(ucw.x), bf_hi(ucw.x)}, (f32x2){bf_lo(ucw.y), bf_hi(ucw.y)}, (f32x2){bf_lo(ucw.z), bf_hi(ucw.z)}, (f32x2){bf_lo(ucw.w), bf_hi(ucw.w)}};
                f32x2 la[4], ip[4];
#pragma unroll
                for (int q = 0; q < 4; ++q) { const f32x4 ar4 = acc[ai][0][m][q >> 1], ai4 = acc[ai][1][m][q >> 1];
                    const f32x2 ar = (q & 1) ? (f32x2){ar4[2], ar4[3]} : (f32x2){ar4[0], ar4[1]}, ag = (q & 1) ? (f32x2){ai4[2], ai4[3]} : (f32x2){ai4[0], ai4[1]};
                    const f32x2 r = rcp_pk(exp2_pk(ar * NL2E + brL[q]) + 1.0f), ig = rcp_pk(exp2_pk(ag * NL2E + biL[q]) + 1.0f);
                    const f32x2 l = cv2[q] * r;
                    const f32x2 a2 = exp2_pk(l * (2.0f * 1.4426950408889634f));
                    f32x2 om = a2 * -1.0f + 1.0f; om.x = __builtin_amdgcn_sqrtf(fmaxf(om.x, 0.f)); om.y = __builtin_amdgcn_sqrtf(fmaxf(om.y, 0.f));
                    la[q] = l; ip[q] = (om * ig) * uc[q]; }
                v4u w; w.x = cvt_pk_bf16(la[0].x, la[0].y); w.y = cvt_pk_bf16(la[1].x, la[1].y); w.z = cvt_pk_bf16(la[2].x, la[2].y); w.w = cvt_pk_bf16(la[3].x, la[3].y);
                *(v4u*)(LA + off) = w;
                v4u x; x.x = cvt_pk_bf16(ip[0].x, ip[0].y); x.y = cvt_pk_bf16(ip[1].x, ip[1].y); x.z = cvt_pk_bf16(ip[2].x, ip[2].y); x.w = cvt_pk_bf16(ip[3].x, ip[3].y);
                *(v4u*)(INP + off) = x; }
    }
};

struct EpiKV {
    static constexpr bool PERM = false;
    static __device__ __forceinline__ int acol(const Unit&) { return 0; }
    float* out; unsigned char* ws; const float* ss; const float* bfv;
    __device__ __forceinline__ void operator()(const f32x4 (&acc)[2][2][4][2], const Unit& u, int wr, int wc, int fr, int fq) const {
        const int row0 = u.pm * BM + wr * 64 + fr; const bool prompt = u.pm < TP / BM;
        float sv[8]; row_scales(ss, row0, sv);
        if (u.pn < 16) {
            const bool isv = u.pn >= 8; const int col0 = (u.pn & 7) * BM + wc * 32 + 4 * fq;
            const size_t fo = prompt ? (isv ? O_VP : O_KP) : (isv ? O_VS : O_KS), bo = prompt ? (isv ? WS_VP : WS_KP) : (isv ? WS_VS : WS_KS);
            float* of = out + fo; bf16_t* ob = (bf16_t*)(ws + bo);
#pragma unroll
            for (int ai = 0; ai < 2; ++ai)
#pragma unroll
                for (int m = 0; m < 4; ++m) { const int row = row0 + ai * HALF + m * 16; const float s = sv[ai * 4 + m];
                    size_t offf, offb;
                    if (prompt) { offf = (size_t)row * DM + col0; offb = offf; }
                    else { const int rsm = row - TP; offf = (size_t)rsm * DM + col0; offb = offf; }
#pragma unroll
                    for (int bj = 0; bj < 2; ++bj)
#pragma unroll
                        for (int n = 0; n < 2; ++n) { const f32x4 v = acc[ai][bj][m][n] * s; __builtin_nontemporal_store(v, (f32x4*)(of + offf + bj * HALF + n * 16));
                            v2u w; w.x = cvt_pk_bf16(v[0], v[1]); w.y = cvt_pk_bf16(v[2], v[3]); *(v2u*)(ob + offb + bj * HALF + n * 16) = w; } }
        } else if (wc == 0) {
            const f32x4 b4 = *(const f32x4*)(bfv + 4 * fq);
            float* lf = out + (prompt ? O_LFP : O_LFS);
#pragma unroll
            for (int ai = 0; ai < 2; ++ai)
#pragma unroll
                for (int m = 0; m < 4; ++m) { const int row = row0 + ai * HALF + m * 16; const float s = sv[ai * 4 + m];
                    f32x4 o;
#pragma unroll
                    for (int j = 0; j < 4; ++j) { const float z = acc[ai][0][m][0][j] * s + b4[j]; o[j] = fminf(z, 0.f) - log1pf(__expf(-fabsf(z))); }
                    *(f32x4*)(lf + (size_t)(prompt ? row : row - TP) * NH + 4 * fq) = o; }
        }
    }
};

struct EpiQG {
    static constexpr bool PERM = true;
    static __device__ __forceinline__ int acol(const Unit&) { return 0; }
    bf16_t* Q; bf16_t* SG; const float* ss;
    __device__ __forceinline__ void operator()(const f32x4 (&acc)[2][2][4][2], const Unit& u, int wr, int wc, int fr, int fq) const {
        const bool isg = u.pn >= 8; const int row0 = u.pm * BM + wr * 64 + fr, col0 = (u.pn & 7) * BM + wc * 32 + 8 * fq; bf16_t* dst = isg ? SG : Q;
        float sv[8]; row_scales(ss, row0, sv);
#pragma unroll
        for (int ai = 0; ai < 2; ++ai)
#pragma unroll
            for (int m = 0; m < 4; ++m) { const int row = row0 + ai * HALF + m * 16; const float s = sv[ai * 4 + m], sL = s * -1.4426950408889634f;
#pragma unroll
                for (int bj = 0; bj < 2; ++bj) { f32x2 o[4];
#pragma unroll
                    for (int n = 0; n < 2; ++n) { const f32x4 a4 = acc[ai][bj][m][n]; const f32x2 a0 = {a4[0], a4[1]}, a1 = {a4[2], a4[3]};
                        if (isg) { o[2 * n] = sigmoid_scaled_pk(a0, sL); o[2 * n + 1] = sigmoid_scaled_pk(a1, sL); } else { o[2 * n] = a0 * s; o[2 * n + 1] = a1 * s; } }
                    v4u w; w.x = cvt_pk_bf16(o[0].x, o[0].y); w.y = cvt_pk_bf16(o[1].x, o[1].y); w.z = cvt_pk_bf16(o[2].x, o[2].y); w.w = cvt_pk_bf16(o[3].x, o[3].y);
                    *(v4u*)(dst + (size_t)row * DM + col0 + bj * HALF) = w; } }
    }
};
}

namespace fox {
constexpr int D = 128, NW = 8, QBLK = 32, KVBLK = 64, QB = NW * QBLK, PITCH = DM;
constexpr int SHM_V = KVBLK * D * 2, SHM_K = KVBLK * D * 2;
constexpr int NSTG = 4, OFF_K = NSTG * SHM_V, OFF_OST_S = 2 * SHM_V, OFF_WS = 132096, OFF_CB = OFF_WS + NW * 64 * 4, OFF_QP = 135168, OFF_U = OFF_QP + NW * 2048, LDS_BYTES = OFF_U + NW * 256;
static_assert(OFF_K + NSTG * SHM_K == 131072 && OFF_CB + NSTG * 256 <= OFF_QP, "attention LDS map");
constexpr float SCALE = ATT_SCALE, THR = 8.f;

#define KSWZ(row, colB) ((row) * 256 + ((colB) ^ (((row) & 7) << 4)))
#define SBAR() __builtin_amdgcn_sched_barrier(0)
__device__ __forceinline__ int v_st(int k, int c) { const int kk = (k & ~0xC) | ((k & 4) << 1) | ((k & 8) >> 1); return ((kk >> 3) * 4 + (c >> 5)) * 512 + ((kk & 7) * 32 + (c & 31)) * 2; }
__device__ __forceinline__ int v_rd_base(int lane) { return ((lane & 3) << 3) | (((lane >> 2) & 3) << 6) | (((lane >> 4) & 1) << 5) | (((lane >> 5) & 1) << 8); }
constexpr int v_rd_off(int d0, int ks, int half) { return d0 * 512 + ks * 4096 + half * 2048; }
__device__ __forceinline__ int crow(int r, int hi) { return (r & 3) + 8 * (r >> 2) + 4 * hi; }
__device__ __forceinline__ bf16x8 load8(const bf16* p) { return *reinterpret_cast<const bf16x8*>(p); }

__device__ __forceinline__ void mask_tile(f32x16& p0, f32x16& p1, int dq) {
    const float NEG = -__builtin_inff();
#pragma unroll
    for (int r = 0; r < 16; ++r) {
        const int c = (r & 3) + 8 * (r >> 2);
        if (dq - c < 0) p0[r] = NEG;
        if (dq - c - 32 < 0) p1[r] = NEG;
    }
}
__device__ __forceinline__ void partialSM(f32x16& p0, f32x16& p1, float& m_reg, float& mn, float& alpha) {
    float pmax = p0[0]; for (int r = 1; r < 16; ++r) pmax = fmaxf(pmax, p0[r]); for (int r = 0; r < 16; ++r) pmax = fmaxf(pmax, p1[r]);
    { auto rr = __builtin_amdgcn_permlane32_swap(__float_as_uint(pmax), __float_as_uint(pmax), false, false);
      pmax = fmaxf(__uint_as_float(rr[0]), __uint_as_float(rr[1])); }
    constexpr float C2 = 1.4426950408889634f * SCALE;
    if (__builtin_expect(__all((pmax - m_reg) * SCALE <= THR), 1)) { mn = m_reg; alpha = 1.f; }
    else { mn = fmaxf(m_reg, pmax); alpha = __builtin_amdgcn_exp2f((m_reg - mn) * C2); m_reg = mn; }
    const float mnL = -mn * C2;
    for (int r = 0; r < 16; ++r) p0[r] = fmaf(p0[r], C2, mnL); for (int r = 0; r < 16; ++r) p1[r] = fmaf(p1[r], C2, mnL);
    for (int r = 0; r < 16; ++r) p0[r] = __builtin_amdgcn_exp2f(p0[r]);
}
__device__ __forceinline__ void partialSM_z(f32x16& p0, f32x16& p1, float& m_reg, float& mn, float& alpha, bool& sk) {
    float pmax = p0[0]; for (int r = 1; r < 16; ++r) pmax = fmaxf(pmax, p0[r]); for (int r = 0; r < 16; ++r) pmax = fmaxf(pmax, p1[r]);
    { auto rr = __builtin_amdgcn_permlane32_swap(__float_as_uint(pmax), __float_as_uint(pmax), false, false);
      pmax = fmaxf(__uint_as_float(rr[0]), __uint_as_float(rr[1])); }
    constexpr float C2 = 1.4426950408889634f * SCALE;
    sk = __all((pmax - m_reg) * C2 < -128.f);
    if (sk) { mn = m_reg; alpha = 1.f; return; }
    if (__builtin_expect(__all((pmax - m_reg) * SCALE <= THR), 1)) { mn = m_reg; alpha = 1.f; }
    else { mn = fmaxf(m_reg, pmax); alpha = __builtin_amdgcn_exp2f((m_reg - mn) * C2); m_reg = mn; }
    const float mnL = -mn * C2;
    for (int r = 0; r < 16; ++r) p0[r] = fmaf(p0[r], C2, mnL); for (int r = 0; r < 16; ++r) p1[r] = fmaf(p1[r], C2, mnL);
    for (int r = 0; r < 16; ++r) p0[r] = __builtin_amdgcn_exp2f(p0[r]);
}
__device__ __forceinline__ void finishSM(f32x16& p0, f32x16& p1, float alpha, float& l_reg, bf16x8& pa0, bf16x8& pa1, bf16x8& pa2, bf16x8& pa3) {
    for (int r = 0; r < 16; ++r) p1[r] = __builtin_amdgcn_exp2f(p1[r]);
    float ps = 0; for (int r = 0; r < 16; ++r) ps += p0[r]; for (int r = 0; r < 16; ++r) ps += p1[r];
    { auto rr = __builtin_amdgcn_permlane32_swap(__float_as_uint(ps), __float_as_uint(ps), false, false);
      ps = __uint_as_float(rr[0]) + __uint_as_float(rr[1]); }
    l_reg = l_reg * alpha + ps;
#define PK4(P, B_, OUT) do { unsigned a0 = cvt_pk_bf16(P[B_+0], P[B_+1]), a1 = cvt_pk_bf16(P[B_+2], P[B_+3]);                          \
        unsigned b0 = cvt_pk_bf16(P[B_+4], P[B_+5]), b1 = cvt_pk_bf16(P[B_+6], P[B_+7]);                                             \
        auto r0 = __builtin_amdgcn_permlane32_swap(a0, b0, false, false); auto r1 = __builtin_amdgcn_permlane32_swap(a1, b1, false, false); \
        v4u w = {r0[0], r1[0], r0[1], r1[1]}; OUT = *reinterpret_cast<bf16x8*>(&w); } while (0)
    PK4(p0, 0, pa0); PK4(p0, 8, pa1); PK4(p1, 0, pa2); PK4(p1, 8, pa3);
#undef PK4
}
template <int KB>
__device__ __forceinline__ void qkt(f32x16& p0, f32x16& p1, const char* K_lds, const char* cb_lds, int r32, int hi, const bf16x8* qr, const char* qpl) {
    const char* cbp = cb_lds + KB * 256 + hi * 16;
#pragma unroll
    for (int g = 0; g < 4; ++g) { const f32x4 c0 = *reinterpret_cast<const f32x4*>(cbp + g * 32), c1 = *reinterpret_cast<const f32x4*>(cbp + 128 + g * 32);
#pragma unroll
        for (int j = 0; j < 4; ++j) { p0[4 * g + j] = c0[j]; p1[4 * g + j] = c1[j]; } }
    const char* kb[4];
#pragma unroll
    for (int dd = 0; dd < 4; ++dd) kb[dd] = K_lds + KB * SHM_K + KSWZ(r32, (dd * 16 + hi * 8) * 2);
#pragma unroll
    for (int d0 = 0; d0 < 8; ++d0) { const char* a = kb[d0 & 3] + (d0 >> 2) * 128;
        bf16x8 b0 = *reinterpret_cast<const bf16x8*>(a);
        bf16x8 b1 = *reinterpret_cast<const bf16x8*>(a + 32 * 256);
        const bf16x8 q = d0 < 6 ? qr[d0] : *reinterpret_cast<const bf16x8*>(qpl + (d0 - 6) * 1024);
        p0 = __builtin_amdgcn_mfma_f32_32x32x16_bf16(b0, q, p0, 0, 0, 0);
        p1 = __builtin_amdgcn_mfma_f32_32x32x16_bf16(b1, q, p1, 0, 0, 0); }
}
template <int VB>
__device__ __forceinline__ void pv_tile(f32x16* o, int vb0, bf16x8 pa0, bf16x8 pa1, bf16x8 pa2, bf16x8 pa3) {
#define TRRD(dst, off) asm volatile("ds_read_b64_tr_b16 %0, %1 offset:%2" : "=&v"(dst) : "v"(vb0), "i"(off) : "memory")
#define PV_D0(d0) do { s16x4 l0, l1, l2, l3, h0, h1, h2, h3; constexpr int b_ = VB * SHM_V + v_rd_off(d0, 0, 0); \
        TRRD(l0, b_); TRRD(h0, b_ + 2048); TRRD(l1, b_ + 4096); TRRD(h1, b_ + 6144); TRRD(l2, b_ + 8192); TRRD(h2, b_ + 10240); TRRD(l3, b_ + 12288); TRRD(h3, b_ + 14336); \
        asm volatile("s_waitcnt lgkmcnt(0)" ::: "memory"); SBAR();   \
        o[d0] = __builtin_amdgcn_mfma_f32_32x32x16_bf16(pa0, (bf16x8){l0[0], l0[1], l0[2], l0[3], h0[0], h0[1], h0[2], h0[3]}, o[d0], 0, 0, 0);   \
        o[d0] = __builtin_amdgcn_mfma_f32_32x32x16_bf16(pa1, (bf16x8){l1[0], l1[1], l1[2], l1[3], h1[0], h1[1], h1[2], h1[3]}, o[d0], 0, 0, 0);   \
        o[d0] = __builtin_amdgcn_mfma_f32_32x32x16_bf16(pa2, (bf16x8){l2[0], l2[1], l2[2], l2[3], h2[0], h2[1], h2[2], h2[3]}, o[d0], 0, 0, 0);   \
        o[d0] = __builtin_amdgcn_mfma_f32_32x32x16_bf16(pa3, (bf16x8){l3[0], l3[1], l3[2], l3[3], h3[0], h3[1], h3[2], h3[3]}, o[d0], 0, 0, 0); } while (0)
    PV_D0(0); PV_D0(1); PV_D0(2); PV_D0(3);
#undef PV_D0
#undef TRRD
}

struct BlockRef { unsigned qo, ko, co; int P0, smp; };
#define BR_NROWS(r) ((r).smp ? SS : 256)
#define BR_SKV(r) ((r).smp ? SKS : SP)
#define BR_Q(r) ((const bf16*)(ws + WS_Q) + (r).qo)
#define BR_O(r) ((bf16*)(ws + WS_Q) + (r).qo)
#define BR_G(r) ((const bf16*)(ws + WS_SG) + (r).qo)
#define BR_K(r) ((const bf16*)(ws + ((r).smp ? WS_KS : WS_KP)) + (r).ko)
#define BR_V(r) ((const bf16*)(ws + ((r).smp ? WS_VS : WS_VP)) + (r).ko)
#define BR_C(r) ((const float*)(ws + ((r).smp ? WS_CS : WS_CP)) + (r).co)
__device__ __forceinline__ int br_nt(const BlockRef& r) { int j = (r.P0 + QB - 1) / KVBLK + 1; const int m = BR_SKV(r) / KVBLK; return j > m ? m : j; }
struct Seam { bf16x8 qr[6]; bf16x8 qp0, qp1; };

#define ROW(p, k0, rr) ((p) + (size_t)((k0) + (rr)) * PITCH + sc)
#define VMW() asm volatile("s_waitcnt vmcnt(0)" ::: "memory")
#define VMWN(n) asm volatile("s_waitcnt vmcnt(%0)" :: "i"(n) : "memory")
#define DMA_IDX() const int sr = tid >> 4, kcs = ((tid & 15) ^ (sr & 7)) * 8;                                                          \
                  const int vkk = ((tid >> 7) << 3) | ((tid >> 2) & 7), vk = (vkk & ~0xC) | ((vkk & 4) << 1) | ((vkk & 8) >> 1), vc = ((tid >> 5) & 3) * 32 + (tid & 3) * 8
#define DMA_K(Kp, Cp, kbase, sg) do { const bf16* kp_ = (Kp) + (size_t)((kbase) + sr) * PITCH + kcs; PG8_LAS unsigned char* kd_ = l3 + OFF_K + (sg) * SHM_K + wid * 1024; \
        __builtin_amdgcn_global_load_lds((const unsigned*)kp_, (PG8_LAS unsigned*)kd_, 16, 0, 0);                                       \
        __builtin_amdgcn_global_load_lds((const unsigned*)(kp_ + (size_t)32 * PITCH), (PG8_LAS unsigned*)(kd_ + 8192), 16, 0, 0);       \
        __builtin_amdgcn_global_load_lds((const unsigned*)((Cp) + (kbase) + lane), (PG8_LAS unsigned*)(l3 + OFF_CB + (sg) * 256), 4, 0, 0); } while (0)
#define DMA_V(Vp, kbase, sg) do { const bf16* vp_ = (Vp) + (size_t)((kbase) + vk) * PITCH + vc; PG8_LAS unsigned char* vd_ = l3 + (sg) * SHM_V + wid * 1024; \
        __builtin_amdgcn_global_load_lds((const unsigned*)vp_, (PG8_LAS unsigned*)vd_, 16, 0, 0);                                       \
        __builtin_amdgcn_global_load_lds((const unsigned*)(vp_ + (size_t)32 * PITCH), (PG8_LAS unsigned*)(vd_ + 8192), 16, 0, 0); } while (0)
#define STEP_SYNC() asm volatile("s_waitcnt vmcnt(10) lgkmcnt(0)\n\ts_barrier" ::: "memory")

#define SQ8(W) (bf_lo(W.x) * bf_lo(W.x) + bf_hi(W.x) * bf_hi(W.x) + bf_lo(W.y) * bf_lo(W.y) + bf_hi(W.y) * bf_hi(W.y) + bf_lo(W.z) * bf_lo(W.z) + bf_hi(W.z) * bf_hi(W.z) + bf_lo(W.w) * bf_lo(W.w) + bf_hi(W.w) * bf_hi(W.w))
#define U_TABLE(BR) do { const int nt_ = br_nt(BR); float qs = 0.f;                                                                     \
        _Pragma("unroll") for (int d0 = 0; d0 < 6; ++d0) { const v4u w = *reinterpret_cast<const v4u*>(&S.qr[d0]); qs += SQ8(w); }      \
        { const v4u w = *reinterpret_cast<const v4u*>(&S.qp0); qs += SQ8(w); } { const v4u w = *reinterpret_cast<const v4u*>(&S.qp1); qs += SQ8(w); } \
        { auto rr = __builtin_amdgcn_permlane32_swap(__float_as_uint(qs), __float_as_uint(qs), false, false); qs = __uint_as_float(rr[0]) + __uint_as_float(rr[1]); } \
        float qn = __builtin_sqrtf(qs);                                                                                                  \
        _Pragma("unroll") for (int o_ = 32; o_ >= 1; o_ >>= 1) qn = fmaxf(qn, __shfl_xor(qn, o_));                                       \
        float kp = lane < nt_ ? ((const float*)(ws + WS_KMX))[((BR).co / SP) * 64 + lane] : 0.f;                                         \
        _Pragma("unroll") for (int o_ = 1; o_ < 64; o_ <<= 1) { const float v_ = __shfl_up(kp, o_); if (lane >= o_) kp = fmaxf(kp, v_); } \
        const float cbl = lane < nt_ ? ((const float*)(ws + WS_CP) + (BR).co)[lane * KVBLK + KVBLK - 1] : 0.f;                                                         \
        *(float*)(lds + OFF_U + wid * 256 + lane * 4) = qn * kp * 1.0001f + cbl; } while (0)
__device__ __forceinline__ void fox_prime(unsigned char* ws, const BlockRef& cur, char* lds, PG8_LAS unsigned char* l3, Seam& S, const int wid) {
    const int lane = lane_id_v(), tid = wid * 64 + lane, r32 = lane & 31, hi = lane >> 5;
    DMA_IDX();
    const int NT = br_nt(cur);
    DMA_K(BR_K(cur), BR_C(cur), (NT - 1) * KVBLK, 0); DMA_K(BR_K(cur), BR_C(cur), (NT - 2) * KVBLK, 1); DMA_K(BR_K(cur), BR_C(cur), (NT - 3) * KVBLK, 2);
    DMA_V(BR_V(cur), (NT - 1) * KVBLK, 0); DMA_V(BR_V(cur), (NT - 2) * KVBLK, 1);
    int qrow = wid * QBLK + r32; if (qrow > BR_NROWS(cur) - 1) qrow = BR_NROWS(cur) - 1;
    for (int d0 = 0; d0 < 6; ++d0) S.qr[d0] = load8(BR_Q(cur) + (size_t)qrow * PITCH + d0 * 16 + hi * 8);
    S.qp0 = load8(BR_Q(cur) + (size_t)qrow * PITCH + 6 * 16 + hi * 8); S.qp1 = load8(BR_Q(cur) + (size_t)qrow * PITCH + 7 * 16 + hi * 8);
    { char* qpw = lds + OFF_QP + wid * 2048 + lane * 16; *(bf16x8*)qpw = S.qp0; *(bf16x8*)(qpw + 1024) = S.qp1; }
    U_TABLE(cur);
    VMW();
    __syncthreads();
}
__device__ __forceinline__ void fox_block(unsigned char* ws, const BlockRef& cur, const BlockRef& nxt, char* lds, PG8_LAS unsigned char* l3, Seam& S, int& stg, const int wid, const int lane) {
    const int tid = wid * 64 + lane, r32 = lane & 31, hi = lane >> 5;
    const int NT = br_nt(cur), NTn = br_nt(nxt);
    const int qlo = cur.P0 + wid * QBLK, qm = qlo + r32 - 4 * hi;
    char* V_lds = lds; char* K_lds = lds + OFF_K; char* cb_lds = lds + OFF_CB;
    float* wsc = (float*)(lds + OFF_WS) + wid * 64; float* li_l = wsc, * al_l = wsc + 32;
    float m_reg = -1e30f, l_reg = 0; f32x16 o[4] = {};
    DMA_IDX();
    const int vb0 = (int)(uintptr_t)V_lds + v_rd_base(lane);
    const char* qpl = lds + OFF_QP + wid * 2048 + lane * 16;
    const unsigned cko = cur.ko, cco = cur.co, nko = nxt.ko, nco = nxt.co;
#define RESC(a) do { if (__any((a) < 1.f)) { if (hi == 0) al_l[r32] = (a); asm volatile("s_waitcnt lgkmcnt(0)" ::: "memory");              \
                     for (int d_ = 0; d_ < 4; ++d_) for (int r = 0; r < 16; ++r) o[d_][r] *= al_l[crow(r, hi)]; } } while (0)
#define KBASE(t) ((NT - 1 - (t)) * KVBLK)
#define MASKT(P0_, P1_, t) do { const int kb_ = KBASE(t); if (kb_ + KVBLK - 1 > qlo) mask_tile(P0_, P1_, qm - kb_); } while (0)
#define ISSUE(t) do { const int tk_ = (t) + 3, tv_ = (t) + 2; const bool kn_ = tk_ >= NTe, vn_ = tv_ >= NTe;                              \
        const int kbk_ = kn_ ? (NTn - 1 - (tk_ - NTe)) * KVBLK : KBASE(tk_), kbv_ = vn_ ? (NTn - 1 - (tv_ - NTe)) * KVBLK : KBASE(tv_);    \
        const unsigned kok_ = kn_ ? nko : cko, cok_ = kn_ ? nco : cco, kov_ = vn_ ? nko : cko;                                        \
        DMA_K((const bf16*)(ws + WS_KP) + kok_, (const float*)(ws + WS_CP) + cok_, kbk_, (s0 + 3) & 3); DMA_V((const bf16*)(ws + WS_VP) + kov_, kbv_, (s0 + 2) & 3); } while (0)
    f32x16 pA0, pA1, pB0, pB1; float mnA, mnB, alA, alB; bf16x8 pa0, pa1, pa2, pa3; bool skA = false, skB = false;
    const bool act = wid * QBLK < BR_NROWS(cur);
    int s0 = stg;
    int NTe = NT;
    ISSUE(0);
    SBAR(); if (act) { qkt<0>(pA0, pA1, K_lds + s0 * SHM_K, cb_lds + s0 * 256, r32, hi, S.qr, qpl);
    MASKT(pA0, pA1, 0); partialSM_z(pA0, pA1, m_reg, mnA, alA, skA); }
    STEP_SYNC(); s0 = (s0 + 1) & 3;
#define HALF_STEP(PX0, PX1, mnX, alX, skX, PY0, PY1, alY, skY, t) do {                                                          \
        ISSUE(t);                                                                                                                 \
        SBAR(); if (act) { qkt<0>(PX0, PX1, K_lds + s0 * SHM_K, cb_lds + s0 * 256, r32, hi, S.qr, qpl);                           \
        if (!skY) finishSM(PY0, PY1, alY, l_reg, pa0, pa1, pa2, pa3); } SBAR();                                                   \
        if (act) { if (!skY) pv_tile<0>(o, vb0 + ((s0 + 3) & 3) * SHM_V, pa0, pa1, pa2, pa3); MASKT(PX0, PX1, (t)); partialSM_z(PX0, PX1, m_reg, mnX, alX, skX); \
                   RESC(alX); }                                                                                                   \
        STEP_SYNC(); s0 = (s0 + 1) & 3; } while (0)
    int t = 1;
    if (NT > 8) {
#pragma unroll 1
        for (; t < 5; t += 2) {
            HALF_STEP(pB0, pB1, mnB, alB, skB, pA0, pA1, alA, skA, t);
            HALF_STEP(pA0, pA1, mnA, alA, skA, pB0, pB1, alB, skB, t + 1);
        }
        float mm = m_reg;
#pragma unroll
        for (int o_ = 32; o_ >= 1; o_ >>= 1) mm = fminf(mm, __shfl_xor(mm, o_));
        const float u_ = *(const float*)(lds + OFF_U + wid * 256 + lane * 4);
        const bool ok_ = lane < NT && (u_ - mm) * (1.4426950408889634f * SCALE) < -130.f;
        const unsigned long long bal_ = __ballot(ok_);
        const int f_ = bal_ == ~0ull ? 64 : __builtin_ctzll(~bal_);
        if (lane == 0) *(int*)li_l = NT - f_;
        asm volatile("s_waitcnt lgkmcnt(0)\n\ts_barrier" ::: "memory");
        int need_ = 0;
#pragma unroll
        for (int w_ = 0; w_ < NW; ++w_) { const int v_ = *(const int*)(lds + OFF_WS + w_ * 256); need_ = v_ > need_ ? v_ : need_; }
        need_ = __builtin_amdgcn_readfirstlane(need_); need_ = (need_ + 1) & ~1; if (need_ < 8) need_ = 8; if (need_ < NTe) NTe = need_;
    }
#pragma unroll 1
    for (; t + 1 < NTe; t += 2) {
        HALF_STEP(pB0, pB1, mnB, alB, skB, pA0, pA1, alA, skA, t);
        HALF_STEP(pA0, pA1, mnA, alA, skA, pB0, pB1, alB, skB, t + 1);
    }
    HALF_STEP(pB0, pB1, mnB, alB, skB, pA0, pA1, alA, skA, NTe - 1);
    int qrow_n = wid * QBLK + r32; if (qrow_n > BR_NROWS(nxt) - 1) qrow_n = BR_NROWS(nxt) - 1;
#pragma unroll
    for (int d0 = 0; d0 < 6; ++d0) S.qr[d0] = load8(BR_Q(nxt) + (size_t)qrow_n * PITCH + d0 * 16 + hi * 8);
    S.qp0 = load8(BR_Q(nxt) + (size_t)qrow_n * PITCH + 6 * 16 + hi * 8); S.qp1 = load8(BR_Q(nxt) + (size_t)qrow_n * PITCH + 7 * 16 + hi * 8);
    SBAR();
    if (act && !skB) { finishSM(pB0, pB1, alB, l_reg, pa0, pa1, pa2, pa3); SBAR(); pv_tile<0>(o, vb0 + ((s0 + 3) & 3) * SHM_V, pa0, pa1, pa2, pa3); }
    stg = s0;
    const int ost_off = wid < 4 ? OFF_K + ((s0 + 3) & 3) * SHM_K + wid * 4096 : ((s0 + 2) & 3) * SHM_V + (wid - 4) * 4096;
    SBAR();
    if (hi == 0) li_l[r32] = l_reg; asm volatile("s_waitcnt lgkmcnt(0)" ::: "memory");
    if (act) {
        int lane_e = lane, wid_e = wid; asm volatile("" : "+v"(lane_e), "+s"(wid_e));
        const int r32_e = lane_e & 31, hi_e = lane_e >> 5;
        const float* li_e = (const float*)(lds + OFF_WS) + wid_e * 64 + 4 * hi_e;
        float rli[16];
#pragma unroll
        for (int r = 0; r < 16; ++r) rli[r] = __builtin_amdgcn_rcpf(li_e[(r & 3) + 8 * (r >> 2)]);
        int ost_e = ost_off; asm volatile("" : "+s"(ost_e));
        bf16* stg = (bf16*)(lds + ost_e);
        bf16* stw = stg + 4 * hi_e * 64 + r32_e;
        const size_t lo_ = (size_t)(wid_e * QBLK + (lane_e >> 3)) * PITCH + (lane_e & 7) * 8;
        bf16* Ow = BR_O(cur) + lo_; const bf16* Gw = BR_G(cur) + lo_;
        const bf16* str = stg + (lane_e >> 3) * 64 + (lane_e & 7) * 8;
        v4u gqa[2][4];
#pragma unroll
        for (int hf = 0; hf < 2; ++hf)
#pragma unroll
            for (int i = 0; i < 4; ++i) gqa[hf][i] = *(const v4u*)(Gw + (size_t)i * 8 * PITCH + hf * 64);
#pragma unroll
        for (int hf = 0; hf < 2; ++hf) {
#pragma unroll
            for (int r = 0; r < 16; ++r) {
#pragma unroll
                for (int d0 = 0; d0 < 2; ++d0) stw[((r & 3) + 8 * (r >> 2)) * 64 + d0 * 32] = (bf16)(cvt_pk_bf16(o[2 * hf + d0][r] * rli[r], 0.f) & 0xffffu); }
            asm volatile("s_waitcnt lgkmcnt(0)" ::: "memory");
#pragma unroll
            for (int i = 0; i < 4; ++i) { const v4u v = *(const v4u*)(str + i * 8 * 64); const v4u gg = gqa[hf][i];
                v4u w; w.x = cvt_pk_bf16(bf_lo(v.x) * bf_lo(gg.x), bf_hi(v.x) * bf_hi(gg.x)); w.y = cvt_pk_bf16(bf_lo(v.y) * bf_lo(gg.y), bf_hi(v.y) * bf_hi(gg.y));
                w.z = cvt_pk_bf16(bf_lo(v.z) * bf_lo(gg.z), bf_hi(v.z) * bf_hi(gg.z)); w.w = cvt_pk_bf16(bf_lo(v.w) * bf_lo(gg.w), bf_hi(v.w) * bf_hi(gg.w));
                *(v4u*)(Ow + (size_t)i * 8 * PITCH + hf * 64) = w; }
            asm volatile("s_waitcnt lgkmcnt(0)" ::: "memory");
        }
    }
    U_TABLE(nxt);
    { char* qpw = lds + OFF_QP + wid * 2048 + lane * 16; *(bf16x8*)qpw = S.qp0; *(bf16x8*)(qpw + 1024) = S.qp1; }
    __syncthreads();
#undef RESC
#undef KBASE
#undef MASKT
#undef ISSUE
#undef HALF_STEP
}
__device__ __forceinline__ void fox_sample(unsigned char* ws, const float* cache_k, const float* cache_v, const int b, const int h, char* lds, const int wid, const int lane) {
    const int tid = wid * 64 + lane, r32 = lane & 31, hi = lane >> 5;
    char* V_lds = lds; char* K_lds = lds + OFF_K; char* cb_lds = lds + OFF_CB;
    constexpr int NT = SKS / KVBLK;
    const float* Cs = (const float*)(ws + WS_CS) + (size_t)(b * NH + h) * SKS;
    if (wid >= 2) {
        if (wid < 6) {
            const int lt = tid - 128, sr = lt >> 4, sc = (lt & 15) * 8;
            const float* kc = cache_k + ((size_t)b * PAST * DM + h * HD + sc); const float* vc = cache_v + ((size_t)b * PAST * DM + h * HD + sc);
            const bf16* kn = (const bf16*)(ws + WS_KS) + ((size_t)b * SS * DM + h * HD + sc); const bf16* vn = (const bf16*)(ws + WS_VS) + ((size_t)b * SS * DM + h * HD + sc);
            f32x4 kf0[4][2], vf0[4][2], kf1[4][2], vf1[4][2]; bf16x8 kh[4], vh[4]; float cv0 = 0.f, cv1 = 0.f, cvh = 0.f;
#define SMP_LOADF(KF, VF, CV, t) do { _Pragma("unroll") for (int j = 0; j < 4; ++j) { const size_t ro = (size_t)((t) * KVBLK + sr + 16 * j) * DM; \
                KF[j][0] = *(const f32x4*)(kc + ro); KF[j][1] = *(const f32x4*)(kc + ro + 4); VF[j][0] = *(const f32x4*)(vc + ro); VF[j][1] = *(const f32x4*)(vc + ro + 4); } \
            if (lt < 64) CV = Cs[(t) * KVBLK + lt]; } while (0)
#define SMP_LOADH(t) do { _Pragma("unroll") for (int j = 0; j < 4; ++j) { const size_t ro = (size_t)(sr + 16 * j) * DM; kh[j] = *(const bf16x8*)(kn + ro); vh[j] = *(const bf16x8*)(vn + ro); } \
            if (lt < 64) cvh = Cs[(t) * KVBLK + lt]; } while (0)
#define SMP_WRITEF(KF, VF, CV, t) do { const int bf_ = (t) & 1; _Pragma("unroll") for (int j = 0; j < 4; ++j) { const int R = sr + 16 * j; \
                v4u a_ = {cvt_pk_bf16(KF[j][0][0], KF[j][0][1]), cvt_pk_bf16(KF[j][0][2], KF[j][0][3]), cvt_pk_bf16(KF[j][1][0], KF[j][1][1]), cvt_pk_bf16(KF[j][1][2], KF[j][1][3])}; \
                v4u b_ = {cvt_pk_bf16(VF[j][0][0], VF[j][0][1]), cvt_pk_bf16(VF[j][0][2], VF[j][0][3]), cvt_pk_bf16(VF[j][1][0], VF[j][1][1]), cvt_pk_bf16(VF[j][1][2], VF[j][1][3])}; \
                *(v4u*)(K_lds + bf_ * SHM_K + KSWZ(R, sc * 2)) = a_; *(v4u*)(V_lds + bf_ * SHM_V + v_st(R, sc)) = b_; } \
            if (lt < 64) *(float*)(cb_lds + bf_ * 256 + lt * 4) = CV; } while (0)
#define SMP_WRITEH(t) do { const int bf_ = (t) & 1; _Pragma("unroll") for (int j = 0; j < 4; ++j) { const int R = sr + 16 * j; \
                *(bf16x8*)(K_lds + bf_ * SHM_K + KSWZ(R, sc * 2)) = kh[j]; *(bf16x8*)(V_lds + bf_ * SHM_V + v_st(R, sc)) = vh[j]; } \
            if (lt < 64) *(float*)(cb_lds + bf_ * 256 + lt * 4) = cvh; } while (0)
#define SMP_BAR() asm volatile("s_waitcnt lgkmcnt(0)\n\ts_barrier" ::: "memory")
            static_assert(NT == 17, "16 cached tiles (f32) + the tile of new keys (bf16)");
            SMP_LOADF(kf0, vf0, cv0, 0); SMP_LOADF(kf1, vf1, cv1, 1); SMP_WRITEF(kf0, vf0, cv0, 0); SMP_LOADF(kf0, vf0, cv0, 2);
            SMP_BAR();
#pragma unroll 1
            for (int t = 0; t < NT - 5; t += 2) {
                SMP_WRITEF(kf1, vf1, cv1, t + 1); SMP_LOADF(kf1, vf1, cv1, t + 3);
                SMP_BAR();
                SMP_WRITEF(kf0, vf0, cv0, t + 2); SMP_LOADF(kf0, vf0, cv0, t + 4);
                SMP_BAR();
            }
            SMP_WRITEF(kf1, vf1, cv1, NT - 4); SMP_LOADF(kf1, vf1, cv1, NT - 2); SMP_BAR();
            SMP_WRITEF(kf0, vf0, cv0, NT - 3); SMP_LOADH(NT - 1); SMP_BAR();
            SMP_WRITEF(kf1, vf1, cv1, NT - 2); SMP_BAR();
            SMP_WRITEH(NT - 1); SMP_BAR();
            SMP_BAR();
#undef SMP_LOADF
#undef SMP_LOADH
#undef SMP_WRITEF
#undef SMP_WRITEH
#undef SMP_BAR
        } else {
            __syncthreads();
            for (int t = 0; t < NT; ++t) __syncthreads();
        }
        return;
    }
    float* wsc = (float*)(lds + OFF_WS) + wid * 64; float* li_l = wsc, * al_l = wsc + 32;
    const size_t qo = ((size_t)TP + (size_t)b * SS) * DM + h * HD;
    bf16x8 qr[8];
#pragma unroll
    for (int d0 = 0; d0 < 8; ++d0) qr[d0] = load8((const bf16*)(ws + WS_Q) + qo + (size_t)(wid * QBLK + r32) * PITCH + d0 * 16 + hi * 8);
    const int vb0 = (int)(uintptr_t)V_lds + v_rd_base(lane);
    const int qm = wid * QBLK + r32 - 4 * hi;
    float m_reg = -1e30f, l_reg = 0; f32x16 o[4] = {};
    __syncthreads();
#define SMP_TILE(KB_, t) do { f32x16 p0, p1; float mn, al; bf16x8 pa0, pa1, pa2, pa3; \
        { const char* cbp = cb_lds + KB_ * 256 + hi * 16; \
          _Pragma("unroll") for (int g = 0; g < 4; ++g) { const f32x4 c0 = *reinterpret_cast<const f32x4*>(cbp + g * 32), c1 = *reinterpret_cast<const f32x4*>(cbp + 128 + g * 32); \
              _Pragma("unroll") for (int j = 0; j < 4; ++j) { p0[4 * g + j] = c0[j]; p1[4 * g + j] = c1[j]; } } \
          const char* kb[4]; _Pragma("unroll") for (int dd = 0; dd < 4; ++dd) kb[dd] = K_lds + KB_ * SHM_K + KSWZ(r32, (dd * 16 + hi * 8) * 2); \
          _Pragma("unroll") for (int d0 = 0; d0 < 8; ++d0) { const char* a = kb[d0 & 3] + (d0 >> 2) * 128; \
              const bf16x8 b0 = *reinterpret_cast<const bf16x8*>(a), b1 = *reinterpret_cast<const bf16x8*>(a + 32 * 256); \
              p0 = __builtin_amdgcn_mfma_f32_32x32x16_bf16(b0, qr[d0], p0, 0, 0, 0); p1 = __builtin_amdgcn_mfma_f32_32x32x16_bf16(b1, qr[d0], p1, 0, 0, 0); } } \
        if ((t) == NT - 1) mask_tile(p0, p1, qm); \
        partialSM(p0, p1, m_reg, mn, al); \
        if (__any(al < 1.f)) { if (hi == 0) al_l[r32] = al; asm volatile("s_waitcnt lgkmcnt(0)" ::: "memory"); \
            for (int d_ = 0; d_ < 4; ++d_) for (int r = 0; r < 16; ++r) o[d_][r] *= al_l[crow(r, hi)]; } \
        finishSM(p0, p1, al, l_reg, pa0, pa1, pa2, pa3); SBAR(); \
        pv_tile<KB_>(o, vb0, pa0, pa1, pa2, pa3); } while (0)
    for (int t = 0; t < NT; t += 2) {
        SMP_TILE(0, t);
        __syncthreads();
        if (t + 1 < NT) { SMP_TILE(1, t + 1); __syncthreads(); }
    }
#undef SMP_TILE
    if (hi == 0) li_l[r32] = l_reg; asm volatile("s_waitcnt lgkmcnt(0)" ::: "memory");
    { float rli[16];
#pragma unroll
      for (int r = 0; r < 16; ++r) rli[r] = __builtin_amdgcn_rcpf(li_l[crow(r, hi)]);
      bf16* stg = (bf16*)(lds + OFF_OST_S) + wid * 2048; bf16* stw = stg + 4 * hi * 64 + r32;
      const size_t lo_ = (size_t)(wid * QBLK + (lane >> 3)) * PITCH + (lane & 7) * 8;
      bf16* Ow = (bf16*)(ws + WS_Q) + qo + lo_; const bf16* Gw = (const bf16*)(ws + WS_SG) + qo + lo_;
      const bf16* str = stg + (lane >> 3) * 64 + (lane & 7) * 8;
      v4u gqa[2][4];
#pragma unroll
      for (int hf = 0; hf < 2; ++hf)
#pragma unroll
          for (int i = 0; i < 4; ++i) gqa[hf][i] = *(const v4u*)(Gw + (size_t)i * 8 * PITCH + hf * 64);
#pragma unroll
      for (int hf = 0; hf < 2; ++hf) {
#pragma unroll
          for (int r = 0; r < 16; ++r) {
#pragma unroll
              for (int d0 = 0; d0 < 2; ++d0) stw[((r & 3) + 8 * (r >> 2)) * 64 + d0 * 32] = (bf16)(cvt_pk_bf16(o[2 * hf + d0][r] * rli[r], 0.f) & 0xffffu); }
          asm volatile("s_waitcnt lgkmcnt(0)" ::: "memory");
#pragma unroll
          for (int i = 0; i < 4; ++i) { const v4u v = *(const v4u*)(str + i * 8 * 64); const v4u gg = gqa[hf][i];
              v4u w; w.x = cvt_pk_bf16(bf_lo(v.x) * bf_lo(gg.x), bf_hi(v.x) * bf_hi(gg.x)); w.y = cvt_pk_bf16(bf_lo(v.y) * bf_lo(gg.y), bf_hi(v.y) * bf_hi(gg.y));
              w.z = cvt_pk_bf16(bf_lo(v.z) * bf_lo(gg.z), bf_hi(v.z) * bf_hi(gg.z)); w.w = cvt_pk_bf16(bf_lo(v.w) * bf_lo(gg.w), bf_hi(v.w) * bf_hi(gg.w));
              *(v4u*)(Ow + (size_t)i * 8 * PITCH + hf * 64) = w; }
          asm volatile("s_waitcnt lgkmcnt(0)" ::: "memory");
      } }
}
#undef ROW
#undef VMW
#undef VMWN
#undef DMA_IDX
#undef SQ8
#undef U_TABLE
#undef DMA_K
#undef DMA_V
#undef STEP_SYNC
}

constexpr int RING_OFF = 0, RING_BYTES = 131072;
constexpr int LDSCTL_OFF = RING_BYTES, MISC_OFF = LDSCTL_OFF + 320;
constexpr int LDS_BYTES = 155648;
static_assert(fox::LDS_BYTES <= LDS_BYTES && fox::OFF_WS >= LDSCTL_OFF + 1024, "attention scratch: ring region + the space above the control words");

#define RLX_AGENT __ATOMIC_RELAXED, __HIP_MEMORY_SCOPE_AGENT
#define LDS_WAIT() asm volatile("s_waitcnt lgkmcnt(0)" ::: "memory")
#define VM_WAIT() asm volatile("s_waitcnt vmcnt(0)" ::: "memory")

#define XB_TMO      128
#define XB_XCNT(j)  (256  + 64 * (j))
#define XB_XSUB(j)  (1280 + 64 * (j))
#define XB_XGEN(j)  (2304 + 64 * (j))
#define XB_TOP      3328
#define XB_TOPGEN   3392
#define XCD_BAR_WORDS 3456
#define XB_SPIN_CAP (1u << 18)
__device__ __forceinline__ unsigned xb_ld(unsigned* p)              { return __hip_atomic_load(p, __ATOMIC_RELAXED, __HIP_MEMORY_SCOPE_AGENT); }
__device__ __forceinline__ unsigned xb_add(unsigned* p, unsigned v) { return __hip_atomic_fetch_add(p, v, __ATOMIC_RELAXED, __HIP_MEMORY_SCOPE_AGENT); }
__device__ __forceinline__ unsigned xb_xcc_id() { return (unsigned)__builtin_amdgcn_s_getreg((3 << 11) | 20) & 0xFu; }
#define XB_SPIN(cond, bar) do { unsigned _sp = 0; while (cond) { __builtin_amdgcn_s_sleep(1); \
    if ((++_sp & 255u) == 0u) { if (xb_ld(&(bar)[XB_TMO])) break; if (_sp > XB_SPIN_CAP) { atomicAdd(&(bar)[XB_TMO], 1u); break; } } } } while (0)
struct XcdBarrier { unsigned* bar; unsigned x; volatile LAS unsigned* st; };
__device__ __forceinline__ XcdBarrier xcd_barrier_post(unsigned* bar, volatile LAS unsigned* st) {
    XcdBarrier b; b.bar = bar; b.x = xb_xcc_id(); b.st = st;
    if (threadIdx.x == 0) (void)xb_add(&bar[XB_XCNT(b.x)], 1u);
    return b;
}
__device__ __forceinline__ void xcd_barrier_complete(unsigned* bar, unsigned x, unsigned& nloc, unsigned& nx) {
    const unsigned G = gridDim.x * gridDim.y * gridDim.z;
    unsigned sum, cnt, mine, sp = 0u;
    for (;;) {
        sum = 0u; cnt = 0u; mine = 0u;
#pragma unroll
        for (unsigned j = 0; j < 16; ++j) { const unsigned c = xb_ld(&bar[XB_XCNT(j)]); sum += c; cnt += (c > 0u) ? 1u : 0u; mine = (j == x) ? c : mine; }
        if (sum == G) break;
        __builtin_amdgcn_s_sleep(1);
        if ((++sp & 255u) == 0u) { if (xb_ld(&bar[XB_TMO])) break; if (sp > XB_SPIN_CAP) { atomicAdd(&bar[XB_TMO], 1u); break; } }
    }
    nloc = mine > 0u ? mine : 1u; nx = cnt > 0u ? cnt : 1u;
}
__device__ __forceinline__ void xcd_barrier(const XcdBarrier& b) {
    asm volatile("s_waitcnt vmcnt(0)" ::: "memory");
    __syncthreads();
    if (threadIdx.x == 0) {
        unsigned* bar = b.bar;
        __builtin_amdgcn_s_waitcnt(0);
        unsigned nloc = b.st[0], nx = b.st[1];
        if (nloc == 0u) { xcd_barrier_complete(bar, b.x, nloc, nx); b.st[0] = nloc; b.st[1] = nx; }
        const unsigned old = xb_add(&bar[XB_XSUB(b.x)], 1u);
        const unsigned gen = old / nloc;
        if (old + 1u == (gen + 1u) * nloc) {
            __builtin_amdgcn_fence(__ATOMIC_RELEASE, "agent");
            asm volatile("s_waitcnt vmcnt(0)" ::: "memory");
            const unsigned og = xb_add(&bar[XB_TOP], 1u);
            const unsigned tg = og / nx;
            if (og + 1u == (tg + 1u) * nx) xb_add(&bar[XB_TOPGEN], 1u);
            else XB_SPIN(xb_ld(&bar[XB_TOPGEN]) == tg, bar);
            __builtin_amdgcn_fence(__ATOMIC_ACQUIRE, "agent");
            xb_add(&bar[XB_XGEN(b.x)], 1u);
            asm volatile("s_waitcnt vmcnt(0)" ::: "memory");
        } else {
            XB_SPIN(xb_ld(&bar[XB_XGEN(b.x)]) == gen, bar);
            __builtin_amdgcn_fence(__ATOMIC_ACQUIRE, "agent");
            asm volatile("s_waitcnt vmcnt(0)" ::: "memory");
        }
    }
    __syncthreads();
}

__device__ __forceinline__ float wave_sum(float v) {
#pragma unroll
    for (int o = 1; o < 64; o <<= 1) v += __shfl_xor(v, o);
    return v;
}
__device__ __forceinline__ void tr_item(const float* W, int N, bf16* WT, int KP_, const float* gain, int k0, int n0, int drow0, LAS float* scr, int lane) {
#pragma unroll 8
    for (int i = 0; i < 32; ++i) { const int kk = 2 * i + (lane >> 5); scr[kk * 33 + (lane & 31)] = W[(size_t)(k0 + kk) * N + n0 + (lane & 31)]; }
    LDS_WAIT(); asm volatile("" ::: "memory");
    const int c = lane & 7;
    float gv[8];
    if (gain) { const f32x4 a = *(const f32x4*)(gain + k0 + 8 * c), b = *(const f32x4*)(gain + k0 + 8 * c + 4);
        gv[0] = a[0]; gv[1] = a[1]; gv[2] = a[2]; gv[3] = a[3]; gv[4] = b[0]; gv[5] = b[1]; gv[6] = b[2]; gv[7] = b[3]; }
    else {
#pragma unroll
        for (int i = 0; i < 8; ++i) gv[i] = 1.f; }
#pragma unroll
    for (int j = 0; j < 4; ++j) { const int n = (lane >> 3) + 8 * j; const LAS float* s = scr + (8 * c) * 33 + n;
        v4u o; o.x = cvt_pk_bf16(s[0 * 33] * gv[0], s[1 * 33] * gv[1]); o.y = cvt_pk_bf16(s[2 * 33] * gv[2], s[3 * 33] * gv[3]);
        o.z = cvt_pk_bf16(s[4 * 33] * gv[4], s[5 * 33] * gv[5]); o.w = cvt_pk_bf16(s[6 * 33] * gv[6], s[7 * 33] * gv[7]);
        *(v4u*)(WT + (size_t)(drow0 + n) * KP_ + k0 + 8 * c) = o; }
    LDS_WAIT(); asm volatile("" ::: "memory");
}
__device__ __forceinline__ void tr_matrix(const float* W, int K, int N, bf16* WT, const float* gain, int mode, int row_off, LAS float* scr, int gw, int NGW, int lane) {
    const int nblk = N / 32, nitems = (K / 64) * nblk;
    for (int it = gw; it < nitems; it += NGW) { const int kb = it / nblk, nb = it - kb * nblk, n0 = nb * 32; int drow0;
        if (mode == 1) { const int up = n0 >= DFF ? 1 : 0, j = n0 - up * DFF; drow0 = (j >> 7) * 256 + up * 128 + (j & 127); } else drow0 = row_off + n0;
        tr_item(W, N, WT, K, gain, kb * 64, n0, drow0, scr, lane); }
}

struct Args { const float* in[26]; float* out; unsigned char* ws; int ph_lo, ph_hi; };

struct Frame {
    LAS unsigned char* lds; volatile LAS unsigned* MISC;
    int wave, vcu, G;
    unsigned char* ws; float* out;
};
#define IN_(k) (args.in[k])

constexpr int TRP = 129;
struct TrTile { const float* W; const float* gain; bf16* WT; int N, K, k0, n0, drow0; };
constexpr int TT_W1 = (DM / 128) * (2 * DFF / 128), TT_W2 = (DFF / 128) * (DM / 128), TT_AIN = (DM / 128) * (2 * DR / 128), TT_WG = 20 * 4, TT_AOUT = (DR / 128) * (DM / 128),
              TT_KV = (DM / 128) * (2 * DM / 128), TT_QG = TT_KV, TT_O = (DM / 128) * (DM / 128);
constexpr int TT_E0 = 4 * TT_W1, TT_E1 = TT_E0 + 4 * TT_W2, TT_E2 = TT_E1 + TT_AIN, TT_E3 = TT_E2 + TT_WG, TT_E4 = TT_E3 + TT_AOUT, TT_E5 = TT_E4 + TT_KV, TT_E6 = TT_E5 + TT_QG, TT_TOTAL = TT_E6 + TT_O;
__device__ __forceinline__ TrTile tr_decode(const Args& args, unsigned char* ws, int t) {
    TrTile r; r.gain = nullptr; int l, mode = 0; size_t dsto;
    if (t < TT_E0)      { const int f = t / TT_W1; l = t - f * TT_W1; r.W = IN_(8) + (size_t)f * DM * 2 * DFF; r.gain = IN_(7) + (size_t)f * DM; r.K = DM; r.N = 2 * DFF; dsto = WS_W1 + (size_t)f * SZ_W1; mode = 1; }
    else if (t < TT_E1) { const int u = t - TT_E0, f = u / TT_W2; l = u - f * TT_W2; r.W = IN_(9) + (size_t)f * DFF * DM; r.K = DFF; r.N = DM; dsto = WS_W2 + (size_t)f * SZ_W2; }
    else if (t < TT_E2) { l = t - TT_E1; r.W = IN_(11); r.gain = IN_(10); r.K = DM; r.N = 2 * DR; dsto = WS_WAIN; }
    else if (t < TT_E3) { const int u = t - TT_E2, gh = u >> 2; l = u & 3; r.W = IN_(14) + (size_t)gh * 256 * 256; r.K = 256; r.N = 256; dsto = WS_WG; mode = 2 + gh; }
    else if (t < TT_E4) { l = t - TT_E3; r.W = IN_(17); r.K = DR; r.N = DM; dsto = WS_WAOUT; }
    else if (t < TT_E5) { l = t - TT_E4; r.W = IN_(19); r.gain = IN_(18); r.K = DM; r.N = 2 * DM; dsto = WS_WKV; }
    else if (t < TT_E6) { l = t - TT_E5; r.W = IN_(23); r.gain = IN_(22); r.K = DM; r.N = 2 * DM; dsto = WS_WQG; }
    else                { l = t - TT_E6; r.W = IN_(24); r.K = DM; r.N = DM; dsto = WS_WO; }
    const int nblk = r.N / 128, kb = l / nblk, nb = l - kb * nblk; r.k0 = kb * 128; r.n0 = nb * 128; r.drow0 = r.n0; r.WT = (bf16*)(ws + dsto);
    if (mode == 1) { const int up = r.n0 >= DFF ? 1 : 0, j = r.n0 - up * DFF; r.drow0 = (j >> 7) * 256 + up * 128; }
    else if (mode >= 2) { const int gh = mode - 2, g = gh / NRH, hb = gh % NRH; r.drow0 = (2 * hb + (r.n0 >> 7)) * 256 + g * 128; }
    return r;
}
__device__ __forceinline__ void convert_tiles(const Args& args, Frame& F, const int t0, const int t1, const int c0 = 0) {
    const int lane = lane_id_v(); const int t = F.wave * 64 + lane;
    unsigned char* ws = F.ws;
    LAS float* scr = (LAS float*)(F.lds + RING_OFF);
    const int lr = t >> 5, lc = (t & 31) * 4;
    const int sc = t & 15, sn = t >> 4;
    f32x4 ld[8];
    const int nc = F.G - c0; if ((int)blockIdx.x < c0) return;
    int tile = t0 + (c0 ? (int)blockIdx.x - c0 : F.vcu);
    if (tile < t1) { const TrTile q = tr_decode(args, ws, tile);
#pragma unroll
        for (int i = 0; i < 8; ++i) ld[i] = *(const f32x4*)(q.W + (size_t)(q.k0 + lr + 16 * i) * q.N + q.n0 + lc); }
    for (; tile < t1; tile += nc) {
        const TrTile q = tr_decode(args, ws, tile);
#pragma unroll
        for (int i = 0; i < 8; ++i) { LAS float* p = scr + (lr + 16 * i) * TRP + lc; p[0] = ld[i][0]; p[1] = ld[i][1]; p[2] = ld[i][2]; p[3] = ld[i][3]; }
        __syncthreads();
        if (tile + nc < t1) { const TrTile qn = tr_decode(args, ws, tile + nc);
#pragma unroll
            for (int i = 0; i < 8; ++i) ld[i] = *(const f32x4*)(qn.W + (size_t)(qn.k0 + lr + 16 * i) * qn.N + qn.n0 + lc); }
        float gv[8];
        if (q.gain) { const f32x4 a = *(const f32x4*)(q.gain + q.k0 + 8 * sc), b = *(const f32x4*)(q.gain + q.k0 + 8 * sc + 4);
            gv[0] = a[0]; gv[1] = a[1]; gv[2] = a[2]; gv[3] = a[3]; gv[4] = b[0]; gv[5] = b[1]; gv[6] = b[2]; gv[7] = b[3]; }
        else {
#pragma unroll
            for (int i = 0; i < 8; ++i) gv[i] = 1.f; }
#pragma unroll
        for (int j = 0; j < 4; ++j) { const int n = sn + 32 * j; const LAS float* sp = scr + (8 * sc) * TRP + n;
            v4u o; o.x = cvt_pk_bf16(sp[0 * TRP] * gv[0], sp[1 * TRP] * gv[1]); o.y = cvt_pk_bf16(sp[2 * TRP] * gv[2], sp[3 * TRP] * gv[3]);
            o.z = cvt_pk_bf16(sp[4 * TRP] * gv[4], sp[5 * TRP] * gv[5]); o.w = cvt_pk_bf16(sp[6 * TRP] * gv[6], sp[7 * TRP] * gv[7]);
            *(v4u*)(q.WT + (size_t)(q.drow0 + n) * q.K + q.k0 + 8 * sc) = o; }
        __syncthreads();
    }
}
__device__ __forceinline__ void p0_prologue(const Args& args, Frame& F) {
    const int lane = lane_id_v(); const int gw = F.vcu * NWAVES + F.wave, NGW = F.G * NWAVES;
    unsigned char* ws = F.ws;
    convert_tiles(args, F, 0, TT_W1);
    {
        const int gt = gw * 64 + lane, NGT = NGW * 64; bf16* WT = (bf16*)(ws + WS_WKV) + (size_t)2 * DM * DM;
        for (int i = gt; i < 256 * DM; i += NGT) { const int n = i / DM, k = i - n * DM; float v = 0.f; if (n < NH) v = IN_(20)[(size_t)k * NH + n] * IN_(18)[k];
            WT[i] = (bf16)(cvt_pk_bf16(v, 0.f) & 0xffffu); }
        float* cl = (float*)(ws + WS_CL);
        for (int i = gt; i < DR; i += NGT) cl[i] = -8.0f * log1pf(expf(-IN_(16)[i]));
    }
    { float* ssq0 = (float*)(ws + SSQ_OFF); bf16* XB = (bf16*)(ws + WS_XB);
      for (int m = gw; m < T; m += NGW) { const float* xr = (m < TP) ? IN_(0) + (size_t)m * DM : IN_(1) + (size_t)(m - TP) * DM;
        float s = 0.f;
#pragma unroll
        for (int j = 0; j < 8; ++j) { const f32x4 v = *((const f32x4*)xr + lane + 64 * j); s += (v[0] * v[0] + v[1] * v[1]) + (v[2] * v[2] + v[3] * v[3]);
            v2u w; w.x = cvt_pk_bf16(v[0], v[1]); w.y = cvt_pk_bf16(v[2], v[3]); *((v2u*)(XB + (size_t)m * DM) + lane + 64 * j) = w; }
        s = wave_sum(s); if (lane == 0) ssq0[m] = s; } }
}

__device__ __forceinline__ void conv_phase(const Args& args, Frame& F) {
    const bf16* U = (const bf16*)(F.ws + WS_U); bf16* UC = (bf16*)(F.ws + WS_UC);
    const float* cw = IN_(12); const float* cb = IN_(13); const float* stc = IN_(2);
    const int gt = (F.vcu * NWAVES + F.wave) * 64 + lane_id_v(), NGT = F.G * NWAVES * 64;
    constexpr int CG = DR / 8, CH = 32;
    constexpr int NIT = (T / CH) * CG;
    for (int it = gt; it < NIT; it += NGT) {
        const int cg = it % CG, chunk = it / CG, c0 = cg * 8, row0 = chunk * CH;
        const bool prompt = row0 < TP; const int t0 = prompt ? (row0 & (SP - 1)) : ((row0 - TP) & (SS - 1)); const int slen = prompt ? SP : SS;
        float w[4][8], bb[8], h[3][8];
#pragma unroll
        for (int k = 0; k < 4; ++k) { const f32x4 a = *(const f32x4*)(cw + k * DR + c0), b = *(const f32x4*)(cw + k * DR + c0 + 4);
#pragma unroll
            for (int j = 0; j < 4; ++j) { w[k][j] = a[j]; w[k][4 + j] = b[j]; } }
        { const f32x4 a = *(const f32x4*)(cb + c0), b = *(const f32x4*)(cb + c0 + 4);
#pragma unroll
            for (int j = 0; j < 4; ++j) { bb[j] = a[j]; bb[4 + j] = b[j]; } }
        if (t0 == 0) {
            if (prompt) {
#pragma unroll
                for (int k = 0; k < 3; ++k)
#pragma unroll
                    for (int j = 0; j < 8; ++j) h[k][j] = 0.f; }
            else { const int b = (row0 - TP) / SS;
#pragma unroll
                for (int k = 0; k < 3; ++k) { const f32x4 a = *(const f32x4*)(stc + ((size_t)b * 3 + k) * DR + c0), bq = *(const f32x4*)(stc + ((size_t)b * 3 + k) * DR + c0 + 4);
#pragma unroll
                    for (int j = 0; j < 4; ++j) { h[k][j] = a[j]; h[k][4 + j] = bq[j]; } } }
        } else {
#pragma unroll
            for (int k = 0; k < 3; ++k) { const v4u q = *(const v4u*)(U + (size_t)(row0 - 3 + k) * DR + c0);
                h[k][0] = bf_lo(q.x); h[k][1] = bf_hi(q.x); h[k][2] = bf_lo(q.y); h[k][3] = bf_hi(q.y); h[k][4] = bf_lo(q.z); h[k][5] = bf_hi(q.z); h[k][6] = bf_lo(q.w); h[k][7] = bf_hi(q.w); }
        }
#pragma unroll 1
        for (int hb = 0; hb < CH; hb += 16) {
            v4u qq[16];
#pragma unroll
            for (int r = 0; r < 16; ++r) qq[r] = *(const v4u*)(U + (size_t)(row0 + hb + r) * DR + c0);
#pragma unroll
            for (int r = 0; r < 16; ++r) { const v4u q = qq[r];
                const f32x2 x2[4] = {(f32x2){bf_lo(q.x), bf_hi(q.x)}, (f32x2){bf_lo(q.y), bf_hi(q.y)}, (f32x2){bf_lo(q.z), bf_hi(q.z)}, (f32x2){bf_lo(q.w), bf_hi(q.w)}}; f32x2 o2[4];
#pragma unroll
                for (int p = 0; p < 4; ++p) { const f32x2 w0 = {w[0][2 * p], w[0][2 * p + 1]}, w1 = {w[1][2 * p], w[1][2 * p + 1]}, w2 = {w[2][2 * p], w[2][2 * p + 1]}, w3 = {w[3][2 * p], w[3][2 * p + 1]};
                    const f32x2 h0 = {h[0][2 * p], h[0][2 * p + 1]}, h1 = {h[1][2 * p], h[1][2 * p + 1]}, h2 = {h[2][2 * p], h[2][2 * p + 1]};
                    o2[p] = (f32x2){bb[2 * p], bb[2 * p + 1]} + w0 * h0 + w1 * h1 + w2 * h2 + w3 * x2[p];
                    h[0][2 * p] = h1.x; h[0][2 * p + 1] = h1.y; h[1][2 * p] = h2.x; h[1][2 * p + 1] = h2.y; h[2][2 * p] = x2[p].x; h[2][2 * p + 1] = x2[p].y; }
                v4u ow; ow.x = cvt_pk_bf16(o2[0].x, o2[0].y); ow.y = cvt_pk_bf16(o2[1].x, o2[1].y); ow.z = cvt_pk_bf16(o2[2].x, o2[2].y); ow.w = cvt_pk_bf16(o2[3].x, o2[3].y);
                *(v4u*)(UC + (size_t)(row0 + hb + r) * DR + c0) = ow; }
        }
        if (t0 + CH == slen) {
            float* dst = prompt ? (F.out + O_CONVP + (size_t)(row0 / SP) * 3 * DR) : (F.out + O_CONVS + (size_t)((row0 - TP) / SS) * 3 * DR);
#pragma unroll
            for (int k = 0; k < 3; ++k) { *(f32x4*)(dst + (size_t)k * DR + c0) = (f32x4){h[k][0], h[k][1], h[k][2], h[k][3]}; *(f32x4*)(dst + (size_t)k * DR + c0 + 4) = (f32x4){h[k][4], h[k][5], h[k][6], h[k][7]}; }
        }
    }
}

#define SC_UNPK(v, j) (((j) & 1) ? bf_hi(((j) >> 1) == 0 ? (v).x : ((j) >> 1) == 1 ? (v).y : ((j) >> 1) == 2 ? (v).z : (v).w) : bf_lo(((j) >> 1) == 0 ? (v).x : ((j) >> 1) == 1 ? (v).y : ((j) >> 1) == 2 ? (v).z : (v).w))
#define SC_LOAD(base) do { _Pragma("unroll") for (int r = 0; r < 8; ++r) { la[r] = *(const v4u*)(LA + (base) + (size_t)r * DR); xi[r] = *(const v4u*)(INP + (base) + (size_t)r * DR); gg[r] = *(const v4u*)(GG + (base) + (size_t)r * DR); } } while (0)
#define SC_COMP(v, p) ((p) == 0 ? (v).x : (p) == 1 ? (v).y : (p) == 2 ? (v).z : (v).w)
#define SC_PAIR(v, p) ((f32x2){bf_lo(SC_COMP(v, p)), bf_hi(SC_COMP(v, p))})
#define SC_SWEEP1() do { f32x2 A2_[4], H2_[4]; _Pragma("unroll") for (int p = 0; p < 4; ++p) { A2_[p] = (f32x2){1.f, 1.f}; H2_[p] = (f32x2){0.f, 0.f}; } \
        _Pragma("unroll") for (int r = 0; r < 8; ++r) _Pragma("unroll") for (int p = 0; p < 4; ++p) { const f32x2 a = exp2_pk2(SC_PAIR(la[r], p) * L2E); H2_[p] = a * H2_[p] + SC_PAIR(xi[r], p); A2_[p] = A2_[p] * a; } \
        _Pragma("unroll") for (int p = 0; p < 4; ++p) { Ai[2 * p] = A2_[p].x; Ai[2 * p + 1] = A2_[p].y; Hi[2 * p] = H2_[p].x; Hi[2 * p + 1] = H2_[p].y; } \
        _Pragma("unroll") for (int d = 1; d < 8; d <<= 1) _Pragma("unroll") for (int j = 0; j < 8; ++j) { const float pa = __shfl_up(Ai[j], 8 * d), ph = __shfl_up(Hi[j], 8 * d); if (s >= d) { Hi[j] = Ai[j] * ph + Hi[j]; Ai[j] = Ai[j] * pa; } } \
        _Pragma("unroll") for (int j = 0; j < 8; ++j) { const float pa = __shfl_up(Ai[j], 8), ph = __shfl_up(Hi[j], 8); Ae[j] = s ? pa : 1.f; He[j] = s ? ph : 0.f; } } while (0)
#define SC_SWEEP2(base) do { f32x2 h2_[4]; _Pragma("unroll") for (int p = 0; p < 4; ++p) h2_[p] = (f32x2){Ae[2 * p], Ae[2 * p + 1]} * (f32x2){mine[2 * p], mine[2 * p + 1]} + (f32x2){He[2 * p], He[2 * p + 1]}; \
        _Pragma("unroll") for (int r = 0; r < 8; ++r) { f32x2 o_[4]; \
            _Pragma("unroll") for (int p = 0; p < 4; ++p) { const f32x2 a = exp2_pk2(SC_PAIR(la[r], p) * L2E); h2_[p] = a * h2_[p] + SC_PAIR(xi[r], p); o_[p] = h2_[p] * SC_PAIR(gg[r], p); } \
            v4u w_; w_.x = cvt_pk_bf16(o_[0].x, o_[0].y); w_.y = cvt_pk_bf16(o_[1].x, o_[1].y); w_.z = cvt_pk_bf16(o_[2].x, o_[2].y); w_.w = cvt_pk_bf16(o_[3].x, o_[3].y); \
            *(v4u*)(GG + (base) + (size_t)r * DR) = w_; } \
        _Pragma("unroll") for (int p = 0; p < 4; ++p) { h[2 * p] = h2_[p].x; h[2 * p + 1] = h2_[p].y; } } while (0)
__device__ __forceinline__ f32x2 exp2_pk2(f32x2 t) { f32x2 e; e.x = __builtin_amdgcn_exp2f(t.x); e.y = __builtin_amdgcn_exp2f(t.y); return e; }
__device__ __forceinline__ void scan_phase(const Args& args, Frame& F) {
    const bf16* LA = (const bf16*)(F.ws + WS_LA); const bf16* INP = (const bf16*)(F.ws + WS_INP); bf16* GG = (bf16*)(F.ws + WS_GG);
    LAS float* sT = (LAS float*)(F.lds + RING_OFF);
    constexpr float L2E = 1.4426950408889634f;
    const int lane = lane_id_v(), s = lane >> 3, o = lane & 7, wave = F.wave;
    constexpr int NPU = BP * (DR / 64), NSU = (BS * (DR / 64)) / 8;
    for (int unit = blockIdx.x; unit < NPU + NSU; unit += F.G) {
        v4u la[8], xi[8], gg[8]; float Ai[8], Hi[8], Ae[8], He[8], mine[8], h[8];
        if (unit < NPU) {
            const int b = unit / (DR / 64), cg = unit % (DR / 64), c0 = cg * 64 + o * 8;
            float blk[8];
#pragma unroll
            for (int j = 0; j < 8; ++j) blk[j] = 0.f;
            for (int it = 0; it < 8; ++it) {
                const size_t base = ((size_t)b * SP + (size_t)(it * 512 + wave * 64 + s * 8)) * DR + c0;
                SC_LOAD(base);
                SC_SWEEP1();
                LAS float* st = sT + (it & 1) * (8 * 64 * 2);
                if (s == 7) {
#pragma unroll
                    for (int j = 0; j < 8; ++j) { st[(wave * 64 + o * 8 + j) * 2] = Ai[j]; st[(wave * 64 + o * 8 + j) * 2 + 1] = Hi[j]; } }
                __syncthreads();
#pragma unroll
                for (int w = 0; w < 8; ++w) {
#pragma unroll
                    for (int j = 0; j < 8; ++j) { const float aw = st[(w * 64 + o * 8 + j) * 2], hw = st[(w * 64 + o * 8 + j) * 2 + 1]; if (w == wave) mine[j] = blk[j]; blk[j] = aw * blk[j] + hw; } }
                SC_SWEEP2(base);
            }
            if (wave == 7 && s == 7) { float* dst = F.out + O_HP + (size_t)b * DR + c0; *(f32x4*)dst = (f32x4){h[0], h[1], h[2], h[3]}; *(f32x4*)(dst + 4) = (f32x4){h[4], h[5], h[6], h[7]}; }
            __syncthreads();
        } else {
            const int su = (unit - NPU) * 8 + wave, b = su / (DR / 64), cg = su % (DR / 64), c0 = cg * 64 + o * 8;
            const size_t base = ((size_t)TP + (size_t)(b * SS + s * 8)) * DR + c0;
            SC_LOAD(base);
            { const float* h0 = IN_(3) + (size_t)b * DR + c0; const f32x4 a = *(const f32x4*)h0, c = *(const f32x4*)(h0 + 4);
              mine[0] = a[0]; mine[1] = a[1]; mine[2] = a[2]; mine[3] = a[3]; mine[4] = c[0]; mine[5] = c[1]; mine[6] = c[2]; mine[7] = c[3]; }
            SC_SWEEP1();
            SC_SWEEP2(base);
            if (s == 7) { float* dst = F.out + O_HS + (size_t)b * DR + c0; *(f32x4*)dst = (f32x4){h[0], h[1], h[2], h[3]}; *(f32x4*)(dst + 4) = (f32x4){h[4], h[5], h[6], h[7]}; }
        }
    }
}
#undef SC_UNPK
#undef SC_COMP
#undef SC_PAIR
#undef SC_LOAD
#undef SC_SWEEP1
#undef SC_SWEEP2

__device__ __forceinline__ void knorm_items(Frame& F) {
    const int lane = lane_id_v(), tid = F.wave * 64 + lane;
    LAS unsigned* mx = (LAS unsigned*)(F.lds + RING_OFF);
    for (int it = F.G - 1 - (int)blockIdx.x; it < BP * 64; it += F.G) {
        const int b = it >> 6, Tt = it & 63;
        __syncthreads();
        if (tid < 16) mx[tid] = 0u;
        __syncthreads();
        const bf16* Kp = (const bf16*)(F.ws + WS_KP) + ((size_t)b * SP + (size_t)Tt * 64) * DM + (tid & 255) * 8;
        float rmax = 0.f;
#pragma unroll 1
        for (int p0 = 0; p0 < 32; p0 += 8) {
            v4u v[8];
#pragma unroll
            for (int i = 0; i < 8; ++i) v[i] = *(const v4u*)(Kp + (size_t)((p0 + i) * 2 + (tid >> 8)) * DM);
#pragma unroll
            for (int i = 0; i < 8; ++i) { const v4u w = v[i];
                float s_ = bf_lo(w.x) * bf_lo(w.x) + bf_hi(w.x) * bf_hi(w.x) + bf_lo(w.y) * bf_lo(w.y) + bf_hi(w.y) * bf_hi(w.y) + bf_lo(w.z) * bf_lo(w.z) + bf_hi(w.z) * bf_hi(w.z) + bf_lo(w.w) * bf_lo(w.w) + bf_hi(w.w) * bf_hi(w.w);
                s_ += __shfl_xor(s_, 1); s_ += __shfl_xor(s_, 2); s_ += __shfl_xor(s_, 4); s_ += __shfl_xor(s_, 8);
                rmax = fmaxf(rmax, s_); }
        }
        if ((lane & 15) == 0) atomicMax((unsigned*)(mx + ((tid & 255) >> 4)), __float_as_uint(rmax));
        __syncthreads();
        if (tid < 16) ((float*)(F.ws + WS_KMX))[((size_t)b * NH + tid) * 64 + Tt] = __builtin_sqrtf(__uint_as_float(mx[tid]));
    }
    __syncthreads();
}
__device__ __forceinline__ void cumsum_items(const Args& args, Frame& F) {
    const int item = (F.G - 1 - (int)blockIdx.x) * NWAVES + F.wave;
    const int lane = lane_id_v();
    for (int it = item; it < BP * NH + BS * NH; it += F.G * NWAVES) {
        if (it < BP * NH) { const int b = it / NH, h = it % NH; const float* lf = F.out + O_LFP + ((size_t)b * SP + (size_t)lane * 64) * NH + h;
            float s = 0.f;
            for (int t = 0; t < 64; ++t) s += lf[(size_t)t * NH];
            float incl = s;
#pragma unroll
            for (int o = 1; o < 64; o <<= 1) { const float v = __shfl_up(incl, o); if (lane >= o) incl += v; }
            float run = incl - s; float* dst = (float*)(F.ws + WS_CP) + ((size_t)b * NH + h) * SP + lane * 64;
            for (int t = 0; t < 64; ++t) { run += lf[(size_t)t * NH]; dst[t] = -run * INV_ATT_SCALE; }
        } else { const int r = it - BP * NH, b = r / NH, h = r % NH; const float* cl = IN_(6) + (size_t)b * PAST * NH + h; const float* lf = F.out + O_LFS + (size_t)b * SS * NH + h;
            float s = 0.f;
            for (int t = 0; t < 17; ++t) { const int p = lane * 17 + t; s += (p < PAST) ? cl[(size_t)p * NH] : lf[(size_t)(p - PAST) * NH]; }
            float incl = s;
#pragma unroll
            for (int o = 1; o < 64; o <<= 1) { const float v = __shfl_up(incl, o); if (lane >= o) incl += v; }
            float run = incl - s; float* dst = (float*)(F.ws + WS_CS) + ((size_t)b * NH + h) * SKS + lane * 17;
            for (int t = 0; t < 17; ++t) { const int p = lane * 17 + t; run += (p < PAST) ? cl[(size_t)p * NH] : lf[(size_t)(p - PAST) * NH]; dst[t] = -run * INV_ATT_SCALE; }
        }
    }
}

__device__ __forceinline__ void final_norm(const Args& args, Frame& F) {
    const bf16* XB = (const bf16*)(F.ws + WS_XB); const float* ssq = (const float*)(F.ws + SSQ_OFF) + (size_t)6 * T; const float* gn = IN_(25);
    const int gw = F.vcu * NWAVES + F.wave, NGW = F.G * NWAVES, lane = lane_id_v();
    f32x4 gv[8];
#pragma unroll
    for (int j = 0; j < 4; ++j) { gv[2 * j] = *(const f32x4*)(gn + 8 * lane + 512 * j); gv[2 * j + 1] = *(const f32x4*)(gn + 8 * lane + 512 * j + 4); }
    for (int m = gw; m < T; m += NGW) { const float s = __builtin_amdgcn_rsqf(ssq[m] * (1.0f / DM) + RMS_EPS);
        const bf16* xr = XB + (size_t)m * DM + 8 * lane; float* yr = F.out + O_YP + (size_t)m * DM + 8 * lane;
        v4u q[4];
#pragma unroll
        for (int j = 0; j < 4; ++j) q[j] = *(const v4u*)(xr + 512 * j);
#pragma unroll
        for (int j = 0; j < 4; ++j) { const f32x4 a = {bf_lo(q[j].x), bf_hi(q[j].x), bf_lo(q[j].y), bf_hi(q[j].y)}, b = {bf_lo(q[j].z), bf_hi(q[j].z), bf_lo(q[j].w), bf_hi(q[j].w)};
            __builtin_nontemporal_store(a * s * gv[2 * j], (f32x4*)(yr + 512 * j)); __builtin_nontemporal_store(b * s * gv[2 * j + 1], (f32x4*)(yr + 512 * j + 4)); } }
}

__device__ __forceinline__ void splitk_reduce(Frame& F, const float* xin_s, float* ssq, float coef, int first) {
    const float* slab = (const float*)(F.ws + WS_INP); bf16* XB = (bf16*)(F.ws + WS_XB) + (size_t)TP * DM;
    const int lane = lane_id_v(), t = F.wave * 64 + lane;
    for (int rb = blockIdx.x; rb < TS / 4; rb += F.G) {
        const int row = rb * 4 + (t >> 7), col = (t & 127) * 16, pm = row >> 8, pn = col >> 8;
        const bf16* sl = (const bf16*)slab + ((size_t)((pm * 8 + pn) * 8) << 16) + (size_t)(row & 255) * 256 + (col & 255);
        v4u sw[8][2];
#pragma unroll
        for (int sp = 0; sp < 8; ++sp) { sw[sp][0] = *(const v4u*)(sl + ((size_t)sp << 16)); sw[sp][1] = *(const v4u*)(sl + ((size_t)sp << 16) + 8); }
        f32x4 a[4];
#pragma unroll
        for (int j = 0; j < 4; ++j) a[j] = (f32x4){0.f, 0.f, 0.f, 0.f};
#pragma unroll
        for (int sp = 0; sp < 8; ++sp)
#pragma unroll
            for (int hh = 0; hh < 2; ++hh) { const v4u w = sw[sp][hh];
                a[2 * hh] += (f32x4){bf_lo(w.x), bf_hi(w.x), bf_lo(w.y), bf_hi(w.y)}; a[2 * hh + 1] += (f32x4){bf_lo(w.z), bf_hi(w.z), bf_lo(w.w), bf_hi(w.w)}; }
        const size_t off = (size_t)row * DM + col; f32x4 xo[4];
        if (first) {
#pragma unroll
            for (int j = 0; j < 4; ++j) xo[j] = *(const f32x4*)(xin_s + off + 4 * j); }
        else { const v4u w0 = *(const v4u*)(XB + off), w1 = *(const v4u*)(XB + off + 8);
            xo[0] = (f32x4){bf_lo(w0.x), bf_hi(w0.x), bf_lo(w0.y), bf_hi(w0.y)}; xo[1] = (f32x4){bf_lo(w0.z), bf_hi(w0.z), bf_lo(w0.w), bf_hi(w0.w)};
            xo[2] = (f32x4){bf_lo(w1.x), bf_hi(w1.x), bf_lo(w1.y), bf_hi(w1.y)}; xo[3] = (f32x4){bf_lo(w1.z), bf_hi(w1.z), bf_lo(w1.w), bf_hi(w1.w)}; }
        float q = 0.f; unsigned pk[8];
#pragma unroll
        for (int j = 0; j < 4; ++j) { const f32x4 xn = xo[j] + a[j] * coef; q += (xn[0] * xn[0] + xn[1] * xn[1]) + (xn[2] * xn[2] + xn[3] * xn[3]);
            pk[2 * j] = cvt_pk_bf16(xn[0], xn[1]); pk[2 * j + 1] = cvt_pk_bf16(xn[2], xn[3]); }
        *(v4u*)(XB + off) = (v4u){pk[0], pk[1], pk[2], pk[3]}; *(v4u*)(XB + off + 8) = (v4u){pk[4], pk[5], pk[6], pk[7]};
        q = wave_sum(q);
        if (lane == 0) __hip_atomic_fetch_add(ssq + TP + row, q, __ATOMIC_RELAXED, __HIP_MEMORY_SCOPE_AGENT);
    }
}

__device__ __forceinline__ fox::BlockRef att_ref(int item, int pass) {
    fox::BlockRef r;
    if (item < BP * NH * 8) { const int bh = item >> 3, x = (item & 7) ^ ((item & 256) ? 7 : 0), qb = pass ? 15 - x : x, b = bh >> 4, h = bh & 15;
        r.qo = (unsigned)((b * SP + qb * 256) * DM + h * HD); r.ko = (unsigned)(b * SP * DM + h * HD); r.co = (unsigned)((b * NH + h) * SP); r.P0 = qb * 256; r.smp = 0; }
    else { r.qo = 0; r.ko = 0; r.co = 0; r.P0 = 0; r.smp = 0; }
    return r;
}
__device__ __forceinline__ void attn_phase(const Args& args, Frame& F, char* lds) {
    constexpr int NPI = BP * NH * 8;
    const int lane = lane_id_v();
    int item = F.vcu;
    if (item < NPI) {
        int pass = 0; fox::BlockRef cur = att_ref(item, 0);
        fox::Seam S; int stg = 0;
        PG8_LAS unsigned char* l3 = (PG8_LAS unsigned char*)F.lds + RING_OFF;
        fox::fox_prime(F.ws, cur, lds, l3, S, F.wave);
        for (;;) {
            const bool more_pass = (pass == 0), more_item = item + F.G < NPI, last = !more_pass && !more_item;
            int itn = item, passn = pass + 1;
            if (!more_pass) { passn = 0; itn = more_item ? item + F.G : item; }
            const fox::BlockRef nxt = last ? cur : att_ref(itn, passn);
            fox::fox_block(F.ws, cur, nxt, lds, l3, S, stg, F.wave, lane);
            if (last) break;
            cur = nxt; item = itn; pass = passn;
        }
        asm volatile("s_waitcnt vmcnt(0)" ::: "memory");
    }
    for (int s = F.vcu; s < BS * NH; s += F.G) { __syncthreads(); fox::fox_sample(F.ws, IN_(4), IN_(5), s >> 4, s & 15, lds, F.wave, lane); __syncthreads(); }
}

constexpr int NPHASES = 18;
__global__ void __launch_bounds__(NWAVES * 64, 2) fwd(Args args) {
    extern __shared__ __attribute__((aligned(16))) unsigned char lds[];
    Frame F;
    F.lds = (LAS unsigned char*)lds; F.MISC = (volatile LAS unsigned*)(F.lds + MISC_OFF);
    F.wave = __builtin_amdgcn_readfirstlane((int)threadIdx.x >> 6);
    F.G = gridDim.x; { const int bx = blockIdx.x; F.vcu = (F.G % 8 == 0) ? (bx % 8) * (F.G / 8) + bx / 8 : bx; }
    F.ws = args.ws; F.out = args.out;
    unsigned char* ws = args.ws;
    for (int u = threadIdx.x; u < (LDS_BYTES - LDSCTL_OFF) / 4; u += NWAVES * 64) ((LAS unsigned*)(F.lds + LDSCTL_OFF))[u] = 0u;
    __syncthreads();
#if MK_PER_PHASE
#define GRID_BAR() do { } while (0)
#else
    XcdBarrier bar = xcd_barrier_post((unsigned*)(ws + WS_CTL) + CW_BAR, F.MISC + 8);
#define GRID_BAR() xcd_barrier(bar)
#endif
    const int lo = args.ph_lo, hi = args.ph_hi;
#define PROBE_BEGIN(k) const unsigned long long _pt0 = ((PROBE_MASK >> (k)) & 1) ? __builtin_amdgcn_s_memrealtime() : 0ull
#define PROBE_END(k) do { if ((PROBE_MASK >> (k)) & 1) { const unsigned long long _pt1 = __builtin_amdgcn_s_memrealtime(); while (__builtin_amdgcn_s_memrealtime() - _pt1 < _pt1 - _pt0) __builtin_amdgcn_s_sleep(32); } } while (0)
#ifndef PH_MASK
#define PH_MASK 0x3ffff
#endif
#define IN(k) (((PH_MASK >> (k)) & 1) && lo <= (k) && (k) < hi)
#define BOTH(k) (IN(k) && IN((k) + 1))
    float* ssq = (float*)(ws + SSQ_OFF);
    bf16* XB = (bf16*)(ws + WS_XB); bf16* Hb = (bf16*)(ws + WS_H);
    LAS unsigned char* ring = F.lds + RING_OFF;
    const int bx = (int)blockIdx.x;

#define FFN_G1(f, ssin) do { pg8::Gemm g{XB, (const bf16*)(ws + WS_W1 + (size_t)(f) * SZ_W1), T, 2 * DFF, DM, DM}; pg8::StaticOrder S; S.init(T, 2 * DFF, DM, F.G, bx); \
        pg8::EpiSwiGLU E{Hb, ssq + (size_t)(ssin) * T}; pg8::gemm_phase<pg8::EpiSwiGLU, pg8::StaticOrder>(ring, g, S, E, F.wave); } while (0)
#define RES_GEMM(Aptr, Wptr, Kdim, ssout, cf, fst) do { pg8::Gemm g{(const bf16*)(Aptr), (const bf16*)(Wptr), T, DM, (Kdim), (Kdim)}; pg8::ResOrder S; S.init((Kdim), F.G, bx); \
        pg8::EpiRes E{args.in[0], args.in[1], XB, ssq + (size_t)(ssout) * T, (cf), (float*)(ws + WS_INP), (fst)}; pg8::gemm_phase<pg8::EpiRes, pg8::ResOrder>(ring, g, S, E, F.wave); \
        GRID_BAR(); splitk_reduce(F, args.in[1], ssq + (size_t)(ssout) * T, (cf), (fst)); } while (0)

    if (IN(0)) { PROBE_BEGIN(0); p0_prologue(args, F); if (BOTH(0)) GRID_BAR(); PROBE_END(0); }
    if (IN(1)) { PROBE_BEGIN(1); FFN_G1(0, 0); convert_tiles(args, F, TT_E0, TT_E0 + TT_W2, 176); if (BOTH(1)) GRID_BAR(); PROBE_END(1); }
    if (IN(2)) { PROBE_BEGIN(2); RES_GEMM(Hb, ws + WS_W2, DFF, 1, 0.5f, 0); convert_tiles(args, F, TT_E1, TT_E2); if (BOTH(2)) GRID_BAR(); PROBE_END(2); }
    if (IN(3)) { PROBE_BEGIN(3); pg8::Gemm g{XB, (const bf16*)(ws + WS_WAIN), T, 2 * DR, DM, DM}; pg8::StaticOrder S; S.init(T, 2 * DR, DM, F.G, bx);
        pg8::EpiAin E{(bf16*)(ws + WS_GG), (bf16*)(ws + WS_U), ssq + (size_t)1 * T}; pg8::gemm_phase<pg8::EpiAin, pg8::StaticOrder>(ring, g, S, E, F.wave); convert_tiles(args, F, TT_E2, TT_E4, 80); convert_tiles(args, F, TT_W1, 2 * TT_W1, 80); if (BOTH(3)) GRID_BAR(); PROBE_END(3); }
    if (IN(4)) { PROBE_BEGIN(4); conv_phase(args, F); if (BOTH(4)) GRID_BAR(); PROBE_END(4); }
    if (IN(5)) { PROBE_BEGIN(5); pg8::Gemm g{(const bf16*)(ws + WS_UC), (const bf16*)(ws + WS_WG), T, 2 * DR, 256, DR}; pg8::StaticOrder S; S.init(T, 2 * DR, 256, F.G, bx);
        pg8::EpiGates E{(const bf16*)(ws + WS_UC), (bf16*)(ws + WS_LA), (bf16*)(ws + WS_INP), args.in[15], (const float*)(ws + WS_CL)}; pg8::gemm_phase<pg8::EpiGates, pg8::StaticOrder>(ring, g, S, E, F.wave); convert_tiles(args, F, TT_E0 + TT_W2, TT_E0 + 2 * TT_W2, 80); if (BOTH(5)) GRID_BAR(); PROBE_END(5); }
    if (IN(6)) { PROBE_BEGIN(6); scan_phase(args, F); if (BOTH(6)) GRID_BAR(); PROBE_END(6); }
    if (IN(7)) { PROBE_BEGIN(7); RES_GEMM(ws + WS_GG, ws + WS_WAOUT, DR, 2, 1.0f, 0); if (BOTH(7)) GRID_BAR(); PROBE_END(7); }
    if (IN(8)) { PROBE_BEGIN(8); FFN_G1(1, 2); convert_tiles(args, F, TT_E4, TT_E5, 176); if (BOTH(8)) GRID_BAR(); PROBE_END(8); }
    if (IN(9)) { PROBE_BEGIN(9); RES_GEMM(Hb, ws + WS_W2 + SZ_W2, DFF, 3, 0.5f, 0); convert_tiles(args, F, 2 * TT_W1, 3 * TT_W1); if (BOTH(9)) GRID_BAR(); PROBE_END(9); }
    if (IN(10)) { PROBE_BEGIN(10);
        { pg8::Gemm g{XB, (const bf16*)(ws + WS_WKV), T, 2 * DM + 256, DM, DM}; pg8::StaticOrder S; S.init(T, 2 * DM + 256, DM, F.G, bx);
          pg8::EpiKV E{F.out, ws, ssq + (size_t)3 * T, args.in[21]};
          pg8::gemm_phase<pg8::EpiKV, pg8::StaticOrder>(ring, g, S, E, F.wave); }
        FFN_G1(2, 3);
        convert_tiles(args, F, TT_E0 + 2 * TT_W2, TT_E0 + 3 * TT_W2, 176); convert_tiles(args, F, TT_E5, TT_E6, 176); if (BOTH(10)) GRID_BAR(); PROBE_END(10); }
    if (IN(11)) { PROBE_BEGIN(11); RES_GEMM(Hb, ws + WS_W2 + 2 * SZ_W2, DFF, 4, 0.5f, 0); knorm_items(F); if (BOTH(11)) GRID_BAR(); PROBE_END(11); }
    if (IN(12)) { PROBE_BEGIN(12); pg8::Gemm g{XB, (const bf16*)(ws + WS_WQG), T, 2 * DM, DM, DM}; pg8::StaticOrder S; S.init(T, 2 * DM, DM, F.G, bx);
        pg8::EpiQG E{(bf16*)(ws + WS_Q), (bf16*)(ws + WS_SG), ssq + (size_t)4 * T}; pg8::gemm_phase<pg8::EpiQG, pg8::StaticOrder>(ring, g, S, E, F.wave); cumsum_items(args, F);   convert_tiles(args, F, TT_E6, TT_TOTAL, 64); convert_tiles(args, F, 3 * TT_W1, 4 * TT_W1, 64); if (BOTH(12)) GRID_BAR(); PROBE_END(12); }
    if (IN(13)) { PROBE_BEGIN(13); attn_phase(args, F, (char*)lds + RING_OFF); if (BOTH(13)) GRID_BAR(); PROBE_END(13); }
    if (IN(14)) { PROBE_BEGIN(14); RES_GEMM(ws + WS_Q, ws + WS_WO, DM, 5, 1.0f, 0); if (BOTH(14)) GRID_BAR(); PROBE_END(14); }
    if (IN(15)) { PROBE_BEGIN(15); FFN_G1(3, 5); convert_tiles(args, F, TT_E0 + 3 * TT_W2, TT_E0 + 4 * TT_W2, 176); if (BOTH(15)) GRID_BAR(); PROBE_END(15); }
    if (IN(16)) { PROBE_BEGIN(16); RES_GEMM(Hb, ws + WS_W2 + 3 * SZ_W2, DFF, 6, 0.5f, 0); if (BOTH(16)) GRID_BAR(); PROBE_END(16); }
    if (IN(17)) { PROBE_BEGIN(17); final_norm(args, F); PROBE_END(17); }
#undef IN
#undef BOTH
}

extern "C" void kernel_launch(void* const* d_in, const int* in_sizes, int n_in, void* d_out, int out_size, void* d_ws, size_t ws_size, hipStream_t stream) {
    static int grid = 0;
    if (grid == 0) {
        if (n_in != 26 || in_sizes[0] != TP * DM || (size_t)out_size != O_END || ws_size < WS_END) {
            fprintf(stderr, "kernel_launch: shape mismatch (n_in %d, in0 %d, out %d (want %zu), ws %zu (want %zu)); nothing launched\n", n_in, n_in > 0 ? in_sizes[0] : -1, out_size, (size_t)O_END, ws_size, (size_t)WS_END); grid = -1; return; }
        int dev = 0, cus = 0, per_cu = 0;
        if (hipGetDevice(&dev) != hipSuccess || hipDeviceGetAttribute(&cus, hipDeviceAttributeMultiprocessorCount, dev) != hipSuccess) { fprintf(stderr, "kernel_launch: device query failed\n"); grid = -1; return; }
        if (hipFuncSetAttribute((const void*)fwd, hipFuncAttributeMaxDynamicSharedMemorySize, LDS_BYTES) != hipSuccess) { fprintf(stderr, "kernel_launch: hipFuncSetAttribute failed\n"); grid = -1; return; }
        if (hipOccupancyMaxActiveBlocksPerMultiprocessor(&per_cu, (const void*)fwd, NWAVES * 64, LDS_BYTES) != hipSuccess || per_cu < 1)
            fprintf(stderr, "kernel_launch: note: occupancy query reports %d workgroups per CU\n", per_cu);
        (void)hipGetLastError();
        grid = cus;
    }
    if (grid < 0) return;
    if (hipMemsetAsync((char*)d_ws + WS_CTL, 0, CTL_ZERO_BYTES, stream) != hipSuccess) { fprintf(stderr, "kernel_launch: memset failed\n"); return; }
    Args a{};
    for (int i = 0; i < 26; ++i) a.in[i] = (const float*)d_in[i];
    a.out = (float*)d_out; a.ws = (unsigned char*)d_ws;
#if MK_PER_PHASE
    for (int p = 0; p < NPHASES; ++p) { a.ph_lo = p; a.ph_hi = p + 1; hipLaunchKernelGGL(fwd, dim3(grid), dim3(NWAVES * 64), LDS_BYTES, stream, a); }
#else
    a.ph_lo = 0; a.ph_hi = NPHASES;
    hipLaunchKernelGGL(fwd, dim3(grid), dim3(NWAVES * 64), LDS_BYTES, stream, a);
#endif
    const hipError_t le = hipPeekAtLastError();
    if (le != hipSuccess) fprintf(stderr, "kernel_launch: launch failed: %s\n", hipGetErrorName(le));
}
```

```cpp
#include <hip/hip_runtime.h>
#include <hip/hip_bf16.h>
#include <cstdio>
#include <cstdint>

#ifndef PROBE_MASK
#define PROBE_MASK 0
#endif
#ifndef MK_PER_PHASE
#define MK_PER_PHASE 0
#endif

constexpr int DM = 2048, BP = 4, SP = 4096, BS = 16, SS = 64, PAST = 1024;
constexpr int TP = BP * SP, TS = BS * SS, T = TP + TS;
constexpr int DFF = 5632, DR = 2560, NH = 16, HD = 128, NRH = 10;
constexpr int SKS = PAST + SS;
constexpr float RMS_EPS = 1e-6f;
constexpr float ATT_SCALE = 0.08838834764831845f;
constexpr float INV_ATT_SCALE = 11.313708498984761f;

#define GAS __attribute__((address_space(1)))
#define LAS __attribute__((address_space(3)))
typedef unsigned short bf16;
typedef unsigned v4u __attribute__((ext_vector_type(4)));
typedef unsigned v2u __attribute__((ext_vector_type(2)));
typedef float f32x4 __attribute__((ext_vector_type(4)));
typedef float f32x2 __attribute__((ext_vector_type(2)));
typedef float f32x16 __attribute__((ext_vector_type(16)));
typedef short bf16x8 __attribute__((ext_vector_type(8)));
typedef short s16x4 __attribute__((ext_vector_type(4)));
typedef GAS unsigned gu32;

__device__ __forceinline__ unsigned cvt_pk_bf16(float lo, float hi) { unsigned r; asm volatile("v_cvt_pk_bf16_f32 %0, %1, %2" : "=v"(r) : "v"(lo), "v"(hi)); return r; }
__device__ __forceinline__ float bf_lo(unsigned w) { return __uint_as_float(w << 16); }
__device__ __forceinline__ float bf_hi(unsigned w) { return __uint_as_float(w & 0xffff0000u); }
__device__ __forceinline__ int lane_id_v() { int l; asm volatile("v_mbcnt_lo_u32_b32 %0, -1, 0\n\tv_mbcnt_hi_u32_b32 %0, -1, %0" : "=v"(l)); return l; }
__device__ __forceinline__ float fast_sigmoid(float x) { return __builtin_amdgcn_rcpf(1.0f + __builtin_amdgcn_exp2f(-1.4426950408889634f * x)); }

constexpr int NWAVES = 8;
constexpr size_t al4k(size_t x) { return (x + 4095) & ~(size_t)4095; }
constexpr size_t WS_CTL = 0, CTL_ZERO_BYTES = 1u << 20;
constexpr int CW_BAR = 4096;
constexpr size_t SSQ_OFF = 262144;
constexpr int NSSQ = 7;
static_assert(SSQ_OFF + (size_t)NSSQ * T * 4 <= CTL_ZERO_BYTES, "ssq inside the memset region");
constexpr size_t SZ_W1 = (size_t)2 * DFF * DM * 2, SZ_W2 = (size_t)DM * DFF * 2;
constexpr size_t WS_W1 = CTL_ZERO_BYTES;
constexpr size_t WS_W2 = WS_W1 + 4 * SZ_W1;
constexpr size_t WS_WAIN = WS_W2 + 4 * SZ_W2;
constexpr size_t WS_WG = WS_WAIN + (size_t)2 * DR * DM * 2;
constexpr size_t WS_WAOUT = WS_WG + (size_t)2 * DR * 256 * 2;
constexpr size_t WS_WKV = WS_WAOUT + (size_t)DM * DR * 2;
constexpr size_t WS_WQG = WS_WKV + (size_t)(2 * DM + 256) * DM * 2;
constexpr size_t WS_WO = WS_WQG + (size_t)2 * DM * DM * 2;
constexpr size_t WS_CL = WS_WO + (size_t)DM * DM * 2;
constexpr size_t WS_X = al4k(WS_CL + DR * 4);
constexpr size_t WS_XB = WS_X + (size_t)T * DM * 4;
constexpr size_t WS_KMX = WS_X;
constexpr size_t WS_H = WS_XB + (size_t)T * DM * 2;
constexpr size_t SZ_R = (size_t)T * DR * 2, SZ_D = (size_t)T * DM * 2;
constexpr size_t WS_U = WS_H, WS_UC = WS_H + SZ_R;
constexpr size_t WS_LA = WS_U;
constexpr size_t WS_Q = WS_H, WS_SG = WS_H + SZ_D;
constexpr size_t WS_GG = WS_H + (size_t)T * DFF * 2;
constexpr size_t WS_INP = WS_GG + SZ_R;
constexpr size_t WS_KP = WS_INP + SZ_R, WS_VP = WS_KP + (size_t)TP * DM * 2;
constexpr size_t WS_KS = WS_VP + (size_t)TP * DM * 2, WS_VS = WS_KS + (size_t)TS * DM * 2;
constexpr size_t WS_CP = WS_VS + (size_t)TS * DM * 2;
constexpr size_t WS_CS = WS_CP + (size_t)BP * NH * SP * 4;
constexpr size_t WS_END = WS_CS + (size_t)BS * NH * SKS * 4;
static_assert(2 * SZ_R <= (size_t)T * DFF * 2 && 2 * SZ_D <= (size_t)T * DFF * 2, "overlays fit in H");
constexpr size_t O_YP = 0, O_YS = O_YP + (size_t)TP * DM, O_CONVP = O_YS + (size_t)TS * DM, O_HP = O_CONVP + (size_t)BP * 3 * DR, O_KP = O_HP + (size_t)BP * DR,
                 O_VP = O_KP + (size_t)TP * DM, O_LFP = O_VP + (size_t)TP * DM, O_CONVS = O_LFP + (size_t)TP * NH, O_HS = O_CONVS + (size_t)BS * 3 * DR,
                 O_KS = O_HS + (size_t)BS * DR, O_VS = O_KS + (size_t)TS * DM, O_LFS = O_VS + (size_t)TS * DM, O_END = O_LFS + (size_t)TS * NH;

#ifndef PG8_ALIGN_EPI
#define PG8_ALIGN_EPI 1
#endif
namespace pg8 {
#define PG8_LAS __attribute__((address_space(3)))
typedef unsigned short bf16_t;
constexpr int BM = 256, BK = 64, HALF = 128, HTB = HALF * BK * 2, STAGE_BYTES = 8 * HTB, NXCD = 8, WGM = 8;

__host__ __device__ __forceinline__ int lds_byte(int r, int c) { const int st = (r >> 4) * 2 + (c >> 5), rr = r & 15, cc = c & 31, ob = rr * 64 + cc * 2; return st * 1024 + (ob ^ (((ob >> 9) & 1) << 5)); }
__host__ __device__ __forceinline__ void stage_rc(int b, int& R, int& C) { const int st = b / 1024, sb = b % 1024, swz = sb ^ (((sb >> 9) & 1) << 5); R = (st >> 1) * 16 + swz / 64; C = (st & 1) * 32 + (swz % 64) / 2; }
__host__ __device__ __forceinline__ int perm32(int rho) { const int n = rho >> 4, i = rho & 15; return 8 * (i >> 2) + 4 * n + (i & 3); }

struct Unit { int pm, pn, kt0, nkt, split; };
struct Gemm { const bf16_t* A; const bf16_t* Bt; int M, N, K, lda; };

struct StaticOrder {
    int nM, nN, nwg, G, c, nkt;
    __device__ __forceinline__ void init(int M, int N, int K, int G_, int c_) { nM = M / BM; nN = N / BM; nwg = nM * nN; G = G_; c = c_; nkt = K / BK; }
    __device__ __forceinline__ bool next(int i, Unit& u) const {
        const long L = (long)i * G + c; if (L >= nwg) return false;
        int wgid = (int)L; { const int q = nwg / NXCD, r = nwg % NXCD, xcd = wgid % NXCD, off = wgid / NXCD; wgid = (xcd < r ? xcd * (q + 1) : r * (q + 1) + (xcd - r) * q) + off; }
        const int nig = WGM * nN, gid = wgid / nig, fm = gid * WGM, gsz = (nM - fm) < WGM ? (nM - fm) : WGM;
        u.pm = fm + ((wgid % nig) % gsz); u.pn = (wgid % nig) / gsz; u.kt0 = 0; u.nkt = nkt; u.split = -1; return true;
    }
};
struct ResOrder {
    int nkt, G, c;
    __device__ __forceinline__ void init(int K, int G_, int c_) { nkt = K / BK; G = G_; c = c_; }
    __device__ __forceinline__ bool next(int i, Unit& u) const {
        constexpr int nM = TP / BM, nN = DM / BM, nwg = nM * nN;
        const int L = i * G + c;
        if (L >= nwg + 32 * 8) return false;
        int pm, pn, kt0 = 0, nk = nkt, sp = -1;
        if (L < nwg) {
            const int xcd = L % NXCD, off = L / NXCD, rnd = off >> 5, j = off & 31;
            pm = 8 * xcd + 4 * rnd + (j & 3); pn = j >> 2;
        } else {
            const int s = L - nwg, tile = s & 31; sp = s >> 5; pm = nM + (tile >> 3); pn = tile & 7;
            kt0 = 2 * ((sp * nkt) >> 4); nk = 2 * (((sp + 1) * nkt) >> 4) - kt0;
        }
        u.pm = pm; u.pn = pn; u.kt0 = kt0; u.nkt = nk; u.split = sp; return true;
    }
};

template <class Epi, class Sched>
__device__ __forceinline__ void gemm_phase(PG8_LAS unsigned char* lds, const Gemm g, const Sched& S, const Epi& E, const int wid) {
    const int lane = lane_id_v(), tid = wid * 64 + lane, wr = wid >> 2, wc = wid & 3, fr = lane & 15, fq = lane >> 4;
    const int K = g.K, lda = g.lda;
    unsigned voffA[2], voffB[2];
#pragma unroll
    for (int i = 0; i < 2; ++i) { int R, C; stage_rc(tid * 16 + i * 8192, R, C); const int Rb = Epi::PERM ? ((R & ~31) + perm32(R & 31)) : R;
        voffA[i] = (unsigned)(R * lda + C) * 2u; voffB[i] = (unsigned)(Rb * K + C) * 2u; }
    const size_t kstep = (size_t)(BK * 2);
    const size_t hstepA = (size_t)HALF * lda * 2, hstepB = (size_t)HALF * K * 2;
    const size_t tstepA = 2 * hstepA, tstepB = 2 * hstepB;
    const unsigned ldsw = (unsigned)wid * 1024u;
    const int aoff = lds_byte(wr * 64 + fr, fq * 8), boff = lds_byte(wc * 32 + fr, fq * 8);
#define PG8_SA(b, h) (((b) * 2 + (h)) * HTB)
#define PG8_SB(b, h) ((4 + (b) * 2 + (h)) * HTB)
#define PG8_STAGE(bufoff, gbase, voff) do { _Pragma("unroll") for (int _i = 0; _i < 2; ++_i) \
        __builtin_amdgcn_global_load_lds((const unsigned*)((const char*)(gbase) + (voff)[_i]), (PG8_LAS unsigned*)(lds + (bufoff) + ldsw + _i * 8192), 16, 0, 0); } while (0)
#define PG8_LDA(dst, b, h) do { _Pragma("unroll") for (int m = 0; m < 4; ++m) _Pragma("unroll") for (int k = 0; k < 2; ++k) dst[m][k] = *(const PG8_LAS bf16x8*)(lds + PG8_SA(b, h) + aoff + m * 2048 + k * 1024); } while (0)
#define PG8_LDB(dst, b, h) do { _Pragma("unroll") for (int n = 0; n < 2; ++n) _Pragma("unroll") for (int k = 0; k < 2; ++k) dst[n][k] = *(const PG8_LAS bf16x8*)(lds + PG8_SB(b, h) + boff + n * 2048 + k * 1024); } while (0)
#define PG8_MMA(ai, bj, At, Bt) do { __builtin_amdgcn_s_setprio(1); _Pragma("unroll") for (int m = 0; m < 4; ++m) _Pragma("unroll") for (int n = 0; n < 2; ++n) _Pragma("unroll") for (int k = 0; k < 2; ++k) \
        acc[ai][bj][m][n] = __builtin_amdgcn_mfma_f32_16x16x32_bf16(Bt[n][k], At[m][k], acc[ai][bj][m][n], 0, 0, 0); __builtin_amdgcn_s_setprio(0); } while (0)
#define PG8_WAIT_V(n) asm volatile("s_waitcnt vmcnt(" #n ")" ::: "memory")
#define PG8_WAIT_L(n) asm volatile("s_waitcnt lgkmcnt(" #n ")" ::: "memory")
#define PG8_BAR __builtin_amdgcn_s_barrier()
#define PG8_SCHED __builtin_amdgcn_sched_barrier(0)
    Unit cur, nxt; int ui = 0;
    if (!S.next(0, cur)) return;
    f32x4 acc[2][2][4][2];
#pragma unroll
    for (int a = 0; a < 2; ++a)
#pragma unroll
        for (int b = 0; b < 2; ++b)
#pragma unroll
            for (int m = 0; m < 4; ++m)
#pragma unroll
                for (int n = 0; n < 2; ++n) acc[a][b][m][n] = (f32x4){0.f, 0.f, 0.f, 0.f};
    bf16x8 At[4][2], B0[2][2], B1[2][2];
    const char* cA = (const char*)g.A + (size_t)cur.pm * tstepA + (size_t)Epi::acol(cur) * 2 + (size_t)cur.kt0 * kstep; const char* cB = (const char*)g.Bt + (size_t)cur.pn * tstepB + (size_t)cur.kt0 * kstep;
    PG8_STAGE(PG8_SB(0, 0), cB, voffB); PG8_STAGE(PG8_SB(0, 1), cB + hstepB, voffB); PG8_STAGE(PG8_SA(0, 0), cA, voffA); PG8_STAGE(PG8_SA(0, 1), cA + hstepA, voffA);
    if (wr == 1) PG8_BAR;
    PG8_WAIT_V(2); PG8_BAR;
    PG8_STAGE(PG8_SB(1, 0), cB + kstep, voffB); PG8_STAGE(PG8_SA(1, 0), cA + kstep, voffA); PG8_STAGE(PG8_SB(1, 1), cB + hstepB + kstep, voffB);
    PG8_WAIT_V(6); PG8_BAR;
    for (;;) {
        const bool has_next = S.next(ui + 1, nxt);
        const char* nA = has_next ? (const char*)g.A + (size_t)nxt.pm * tstepA + (size_t)Epi::acol(nxt) * 2 + (size_t)nxt.kt0 * kstep : cA; const char* nB = has_next ? (const char*)g.Bt + (size_t)nxt.pn * tstepB + (size_t)nxt.kt0 * kstep : cB;
        const int nt = cur.nkt;
        for (int t = 0; t < nt; t += 2) {
            const bool last = (t == nt - 2);
            const char* a1 = cA + (size_t)(t + 1) * kstep;
            const char* a2 = last ? nA : cA + (size_t)(t + 2) * kstep; const char* b2 = last ? nB : cB + (size_t)(t + 2) * kstep;
            const char* a3 = a2 + kstep; const char* b3 = b2 + kstep;
            PG8_LDB(B0, 0, 0); PG8_LDB(B1, 0, 1); PG8_SCHED; PG8_LDA(At, 0, 0); PG8_STAGE(PG8_SA(1, 1), a1 + hstepA, voffA);
            PG8_WAIT_V(8); PG8_WAIT_L(0); PG8_BAR; PG8_MMA(0, 0, At, B0); PG8_MMA(0, 1, At, B1); PG8_BAR; PG8_SCHED;
            PG8_LDA(At, 0, 1); PG8_STAGE(PG8_SB(0, 0), b2, voffB); PG8_STAGE(PG8_SB(0, 1), b2 + hstepB, voffB); PG8_STAGE(PG8_SA(0, 0), a2, voffA);
            PG8_WAIT_V(8); PG8_WAIT_L(0); PG8_BAR; PG8_MMA(1, 0, At, B0); PG8_MMA(1, 1, At, B1); PG8_BAR; PG8_SCHED;
            PG8_LDB(B0, 1, 0); PG8_LDB(B1, 1, 1); PG8_SCHED; PG8_LDA(At, 1, 0); PG8_STAGE(PG8_SA(0, 1), a2 + hstepA, voffA);
            PG8_WAIT_V(8); PG8_WAIT_L(0); PG8_BAR; PG8_MMA(0, 0, At, B0); PG8_MMA(0, 1, At, B1); PG8_BAR; PG8_SCHED;
            PG8_LDA(At, 1, 1); PG8_STAGE(PG8_SB(1, 0), b3, voffB); PG8_STAGE(PG8_SB(1, 1), b3 + hstepB, voffB); PG8_STAGE(PG8_SA(1, 0), a3, voffA);
            PG8_WAIT_V(8); PG8_WAIT_L(0); PG8_BAR; PG8_MMA(1, 0, At, B0); PG8_MMA(1, 1, At, B1); PG8_BAR; PG8_SCHED;
        }
        if (PG8_ALIGN_EPI) { if (wr == 0) PG8_BAR; }
        E(acc, cur, wr, wc, fr, fq);
        if (!has_next) break;
#pragma unroll
        for (int a = 0; a < 2; ++a)
#pragma unroll
            for (int b = 0; b < 2; ++b)
#pragma unroll
                for (int m = 0; m < 4; ++m)
#pragma unroll
                    for (int n = 0; n < 2; ++n) acc[a][b][m][n] = (f32x4){0.f, 0.f, 0.f, 0.f};
        cur = nxt; cA = nA; cB = nB; ++ui;
        if (PG8_ALIGN_EPI) { if (wr == 1) PG8_BAR; }
    }
    PG8_WAIT_V(0);
    if (!PG8_ALIGN_EPI) { if (wr == 0) PG8_BAR; }
    PG8_BAR;
#undef PG8_SA
#undef PG8_SB
#undef PG8_STAGE
#undef PG8_LDA
#undef PG8_LDB
#undef PG8_MMA
#undef PG8_WAIT_V
#undef PG8_WAIT_L
#undef PG8_BAR
#undef PG8_SCHED
}

__device__ __forceinline__ void row_scales(const float* ss, int row0, float (&sv)[8]) {
#pragma unroll
    for (int i = 0; i < 8; ++i) sv[i] = ss[row0 + (i >> 2) * HALF + (i & 3) * 16];
#pragma unroll
    for (int i = 0; i < 8; ++i) sv[i] = __builtin_amdgcn_rsqf(sv[i] * (1.0f / DM) + RMS_EPS);
}

__device__ __forceinline__ f32x2 exp2_pk(f32x2 t) { f32x2 e; e.x = __builtin_amdgcn_exp2f(t.x); e.y = __builtin_amdgcn_exp2f(t.y); return e; }
__device__ __forceinline__ f32x2 rcp_pk(f32x2 d) { f32x2 r; r.x = __builtin_amdgcn_rcpf(d.x); r.y = __builtin_amdgcn_rcpf(d.y); return r; }
__device__ __forceinline__ f32x2 sigmoid_scaled_pk(f32x2 a, float kL) { return rcp_pk(exp2_pk(a * kL) + 1.0f); }
__device__ __forceinline__ f32x2 gelu_tanh_pk(f32x2 a, float s) {
    const f32x2 x = a * s, x2 = x * x;
    const f32x2 p = x2 * (-1.4426950408889634f * 1.5957691216057308f * 0.044715f) + (-1.4426950408889634f * 1.5957691216057308f);
    return x * rcp_pk(exp2_pk(x * p) + 1.0f);
}
__device__ __forceinline__ f32x2 silu_mul_pk(f32x2 g, f32x2 u, float sL, float s2) {
    const f32x2 t = g * sL; f32x2 e; e.x = __builtin_amdgcn_exp2f(t.x); e.y = __builtin_amdgcn_exp2f(t.y);
    const f32x2 d = e + 1.0f; f32x2 r; r.x = __builtin_amdgcn_rcpf(d.x); r.y = __builtin_amdgcn_rcpf(d.y);
    return (g * u) * (r * s2);
}
struct EpiSwiGLU {
    static constexpr bool PERM = true;
    static __device__ __forceinline__ int acol(const Unit&) { return 0; }
    bf16_t* H; const float* ss;
    __device__ __forceinline__ void operator()(const f32x4 (&acc)[2][2][4][2], const Unit& u, int wr, int wc, int fr, int fq) const {
        const int row0 = u.pm * BM + wr * 64 + fr, col0 = u.pn * 128 + wc * 32 + 8 * fq;
        float sv[8]; row_scales(ss, row0, sv);
#pragma unroll
        for (int ai = 0; ai < 2; ++ai)
#pragma unroll
            for (int m = 0; m < 4; ++m) { const int row = row0 + ai * HALF + m * 16; const float s = sv[ai * 4 + m], sL = s * -1.4426950408889634f, s2 = s * s;
                f32x2 o[4];
#pragma unroll
                for (int n = 0; n < 2; ++n) { const f32x4 g4 = acc[ai][0][m][n], u4 = acc[ai][1][m][n];
                    o[2 * n] = silu_mul_pk((f32x2){g4[0], g4[1]}, (f32x2){u4[0], u4[1]}, sL, s2); o[2 * n + 1] = silu_mul_pk((f32x2){g4[2], g4[3]}, (f32x2){u4[2], u4[3]}, sL, s2); }
                v4u w; w.x = cvt_pk_bf16(o[0].x, o[0].y); w.y = cvt_pk_bf16(o[1].x, o[1].y); w.z = cvt_pk_bf16(o[2].x, o[2].y); w.w = cvt_pk_bf16(o[3].x, o[3].y);
                __builtin_nontemporal_store(w, (v4u*)(H + (size_t)row * DFF + col0)); }
    }
};

struct EpiRes {
    static constexpr bool PERM = true;
    static __device__ __forceinline__ int acol(const Unit&) { return 0; }
    const float* xin_p; const float* xin_s; bf16_t* XB; float* ssq; float coef; float* slab; int first;
    __device__ __forceinline__ void operator()(const f32x4 (&acc)[2][2][4][2], const Unit& u, int wr, int wc, int fr, int fq) const {
        if (u.split >= 0) {
            bf16_t* sl = (bf16_t*)slab + ((size_t)(((u.pm - TP / BM) * 8 + u.pn) * 8 + u.split) << 16) + (size_t)(wr * 64 + fr) * BM + wc * 32 + 8 * fq;
#pragma unroll
            for (int ai = 0; ai < 2; ++ai)
#pragma unroll
                for (int m = 0; m < 4; ++m)
#pragma unroll
                    for (int bj = 0; bj < 2; ++bj) { const f32x4 a = acc[ai][bj][m][0], b = acc[ai][bj][m][1];
                        v4u o; o.x = cvt_pk_bf16(a[0], a[1]); o.y = cvt_pk_bf16(a[2], a[3]); o.z = cvt_pk_bf16(b[0], b[1]); o.w = cvt_pk_bf16(b[2], b[3]);
                        *(v4u*)(sl + (size_t)(ai * HALF + m * 16) * BM + bj * HALF) = o; }
            return; }
        const int row0 = u.pm * BM + wr * 64 + fr, col0 = u.pn * BM + wc * 32 + 8 * fq;
        const float* xin = (u.pm < TP / BM) ? xin_p : (xin_s - (size_t)TP * DM);
        if (first) {
#pragma unroll
            for (int ai = 0; ai < 2; ++ai) { float rs[4];
#pragma unroll
                for (int mp = 0; mp < 4; mp += 2) { f32x4 xl[2][2][2];
#pragma unroll
                    for (int mm = 0; mm < 2; ++mm)
#pragma unroll
                        for (int bj = 0; bj < 2; ++bj) { const size_t off = (size_t)(row0 + ai * HALF + (mp + mm) * 16) * DM + col0 + bj * HALF; xl[mm][bj][0] = *(const f32x4*)(xin + off); xl[mm][bj][1] = *(const f32x4*)(xin + off + 4); }
#pragma unroll
                    for (int mm = 0; mm < 2; ++mm) { const int m = mp + mm; const size_t off = (size_t)(row0 + ai * HALF + m * 16) * DM + col0; float q = 0.f;
#pragma unroll
                        for (int bj = 0; bj < 2; ++bj) { float xn[8];
#pragma unroll
                            for (int e = 0; e < 8; ++e) { xn[e] = xl[mm][bj][e >> 2][e & 3] + acc[ai][bj][m][e >> 2][e & 3] * coef; q += xn[e] * xn[e]; }
                            v4u o; o.x = cvt_pk_bf16(xn[0], xn[1]); o.y = cvt_pk_bf16(xn[2], xn[3]); o.z = cvt_pk_bf16(xn[4], xn[5]); o.w = cvt_pk_bf16(xn[6], xn[7]);
                            *(v4u*)(XB + off + bj * HALF) = o; }
                        q += __shfl_xor(q, 16); q += __shfl_xor(q, 32); rs[m] = q; } }
                { const float v = fq == 0 ? rs[0] : (fq == 1 ? rs[1] : (fq == 2 ? rs[2] : rs[3])); __hip_atomic_fetch_add(ssq + row0 + ai * HALF + fq * 16, v, __ATOMIC_RELAXED, __HIP_MEMORY_SCOPE_AGENT); } }
        } else {
            v4u xw[2][4][2];
#pragma unroll
            for (int ai = 0; ai < 2; ++ai)
#pragma unroll
                for (int m = 0; m < 4; ++m)
#pragma unroll
                    for (int bj = 0; bj < 2; ++bj) xw[ai][m][bj] = *(const v4u*)(XB + (size_t)(row0 + ai * HALF + m * 16) * DM + col0 + bj * HALF);
#pragma unroll
            for (int ai = 0; ai < 2; ++ai) { float rs[4];
#pragma unroll
                for (int m = 0; m < 4; ++m) { const size_t off = (size_t)(row0 + ai * HALF + m * 16) * DM + col0; float q = 0.f;
                    f32x2 q2 = {0.f, 0.f};
#pragma unroll
                    for (int bj = 0; bj < 2; ++bj) { const v4u w = xw[ai][m][bj]; const f32x4 a0 = acc[ai][bj][m][0], a1 = acc[ai][bj][m][1];
                        const f32x2 x0 = (f32x2){bf_lo(w.x), bf_hi(w.x)} + (f32x2){a0[0], a0[1]} * coef, x1 = (f32x2){bf_lo(w.y), bf_hi(w.y)} + (f32x2){a0[2], a0[3]} * coef;
                        const f32x2 x2 = (f32x2){bf_lo(w.z), bf_hi(w.z)} + (f32x2){a1[0], a1[1]} * coef, x3 = (f32x2){bf_lo(w.w), bf_hi(w.w)} + (f32x2){a1[2], a1[3]} * coef;
                        q2 += x0 * x0; q2 += x1 * x1; q2 += x2 * x2; q2 += x3 * x3;
                        v4u o; o.x = cvt_pk_bf16(x0.x, x0.y); o.y = cvt_pk_bf16(x1.x, x1.y); o.z = cvt_pk_bf16(x2.x, x2.y); o.w = cvt_pk_bf16(x3.x, x3.y);
                        *(v4u*)(XB + off + bj * HALF) = o; }
                    q = q2.x + q2.y;
                    q += __shfl_xor(q, 16); q += __shfl_xor(q, 32); rs[m] = q; }
                { const float v = fq == 0 ? rs[0] : (fq == 1 ? rs[1] : (fq == 2 ? rs[2] : rs[3])); __hip_atomic_fetch_add(ssq + row0 + ai * HALF + fq * 16, v, __ATOMIC_RELAXED, __HIP_MEMORY_SCOPE_AGENT); } }
        }
    }
};

struct EpiAin {
    static constexpr bool PERM = true;
    static __device__ __forceinline__ int acol(const Unit&) { return 0; }
    bf16_t* GG; bf16_t* U; const float* ss;
    __device__ __forceinline__ void operator()(const f32x4 (&acc)[2][2][4][2], const Unit& u, int wr, int wc, int fr, int fq) const {
        const bool isu = u.pn >= 10; const int row0 = u.pm * BM + wr * 64 + fr, col0 = (isu ? u.pn - 10 : u.pn) * BM + wc * 32 + 8 * fq; bf16_t* dst = isu ? U : GG;
        float sv[8]; row_scales(ss, row0, sv);
#pragma unroll
        for (int ai = 0; ai < 2; ++ai)
#pragma unroll
            for (int m = 0; m < 4; ++m) { const int row = row0 + ai * HALF + m * 16; const float s = sv[ai * 4 + m];
#pragma unroll
                for (int bj = 0; bj < 2; ++bj) { f32x2 o[4];
#pragma unroll
                    for (int n = 0; n < 2; ++n) { const f32x4 a4 = acc[ai][bj][m][n]; const f32x2 a0 = {a4[0], a4[1]}, a1 = {a4[2], a4[3]};
                        if (isu) { o[2 * n] = a0 * s; o[2 * n + 1] = a1 * s; } else { o[2 * n] = gelu_tanh_pk(a0, s); o[2 * n + 1] = gelu_tanh_pk(a1, s); } }
                    v4u w; w.x = cvt_pk_bf16(o[0].x, o[0].y); w.y = cvt_pk_bf16(o[1].x, o[1].y); w.z = cvt_pk_bf16(o[2].x, o[2].y); w.w = cvt_pk_bf16(o[3].x, o[3].y);
                    *(v4u*)(dst + (size_t)row * DR + col0 + bj * HALF) = w; } }
    }
};

struct EpiGates {
    static constexpr bool PERM = true;
    static __device__ __forceinline__ int acol(const Unit& u) { return (u.pn >> 1) * 256; }
    const bf16_t* UC; bf16_t* LA; bf16_t* INP; const float* gb; const float* cl;
    __device__ __forceinline__ void operator()(const f32x4 (&acc)[2][2][4][2], const Unit& u, int wr, int wc, int fr, int fq) const {
        const int row0 = u.pm * BM + wr * 64 + fr, ch0 = (u.pn >> 1) * 256 + (u.pn & 1) * 128 + wc * 32 + 8 * fq;
        constexpr float NL2E = -1.4426950408889634f;
        f32x2 brL[4], biL[4], cv2[4];
#pragma unroll
        for (int n = 0; n < 2; ++n) { const f32x4 a = *(const f32x4*)(gb + ch0 + 4 * n), b = *(const f32x4*)(gb + DR + ch0 + 4 * n), c = *(const f32x4*)(cl + ch0 + 4 * n);
            brL[2 * n] = (f32x2){a[0], a[1]} * NL2E; brL[2 * n + 1] = (f32x2){a[2], a[3]} * NL2E; biL[2 * n] = (f32x2){b[0], b[1]} * NL2E; biL[2 * n + 1] = (f32x2){b[2], b[3]} * NL2E;
            cv2[2 * n] = (f32x2){c[0], c[1]}; cv2[2 * n + 1] = (f32x2){c[2], c[3]}; }
        v4u ucl[8];
#pragma unroll
        for (int i = 0; i < 8; ++i) ucl[i] = *(const v4u*)(UC + (size_t)(row0 + (i >> 2) * HALF + (i & 3) * 16) * DR + ch0);
#pragma unroll
        for (int ai = 0; ai < 2; ++ai)
#pragma unroll
            for (int m = 0; m < 4; ++m) { const int row = row0 + ai * HALF + m * 16; const size_t off = (size_t)row * DR + ch0;
                const v4u ucw = ucl[ai * 4 + m];
                const f32x2 uc[4] = {(f32x2){bf_lo(ucw.x), bf_hi(ucw.x)}, (f32x2){bf_lo(ucw.y), bf_hi(ucw.y)}, (f32x2){bf_lo(ucw.z), bf_hi(ucw.z)}, (f32x2){bf_lo(ucw.w), bf_hi(ucw.w)}};
                f32x2 la[4], ip[4];
#pragma unroll
                for (int q = 0; q < 4; ++q) { const f32x4 ar4 = acc[ai][0][m][q >> 1], ai4 = acc[ai][1][m][q >> 1];
                    const f32x2 ar = (q & 1) ? (f32x2){ar4[2], ar4[3]} : (f32x2){ar4[0], ar4[1]}, ag = (q & 1) ? (f32x2){ai4[2], ai4[3]} : (f32x2){ai4[0], ai4[1]};
                    const f32x2 r = rcp_pk(exp2_pk(ar * NL2E + brL[q]) + 1.0f), ig = rcp_pk(exp2_pk(ag * NL2E + biL[q]) + 1.0f);
                    const f32x2 l = cv2[q] * r;
                    const f32x2 a2 = exp2_pk(l * (2.0f * 1.4426950408889634f));
                    f32x2 om = a2 * -1.0f + 1.0f; om.x = __builtin_amdgcn_sqrtf(fmaxf(om.x, 0.f)); om.y = __builtin_amdgcn_sqrtf(fmaxf(om.y, 0.f));
                    la[q] = l; ip[q] = (om * ig) * uc[q]; }
                v4u w; w.x = cvt_pk_bf16(la[0].x, la[0].y); w.y = cvt_pk_bf16(la[1].x, la[1].y); w.z = cvt_pk_bf16(la[2].x, la[2].y); w.w = cvt_pk_bf16(la[3].x, la[3].y);
                *(v4u*)(LA + off) = w;
                v4u x; x.x = cvt_pk_bf16(ip[0].x, ip[0].y); x.y = cvt_pk_bf16(ip[1].x, ip[1].y); x.z = cvt_pk_bf16(ip[2].x, ip[2].y); x.w = cvt_pk_bf16(ip[3].x, ip[3].y);
                *(v4u*)(INP + off) = x; }
    }
};

struct EpiKV {
    static constexpr bool PERM = false;
    static __device__ __forceinline__ int acol(const Unit&) { return 0; }
    float* out; unsigned char* ws; const float* ss; const float* bfv;
    __device__ __forceinline__ void operator()(const f32x4 (&acc)[2][2][4][2], const Unit& u, int wr, int wc, int fr, int fq) const {
        const int row0 = u.pm * BM + wr * 64 + fr; const bool prompt = u.pm < TP / BM;
        float sv[8]; row_scales(ss, row0, sv);
        if (u.pn < 16) {
            const bool isv = u.pn >= 8; const int col0 = (u.pn & 7) * BM + wc * 32 + 4 * fq;
            const size_t fo = prompt ? (isv ? O_VP : O_KP) : (isv ? O_VS : O_KS), bo = prompt ? (isv ? WS_VP : WS_KP) : (isv ? WS_VS : WS_KS);
            float* of = out + fo; bf16_t* ob = (bf16_t*)(ws + bo);
#pragma unroll
            for (int ai = 0; ai < 2; ++ai)
#pragma unroll
                for (int m = 0; m < 4; ++m) { const int row = row0 + ai * HALF + m * 16; const float s = sv[ai * 4 + m];
                    size_t offf, offb;
                    if (prompt) { offf = (size_t)row * DM + col0; offb = offf; }
                    else { const int rsm = row - TP; offf = (size_t)rsm * DM + col0; offb = offf; }
#pragma unroll
                    for (int bj = 0; bj < 2; ++bj)
#pragma unroll
                        for (int n = 0; n < 2; ++n) { const f32x4 v = acc[ai][bj][m][n] * s; __builtin_nontemporal_store(v, (f32x4*)(of + offf + bj * HALF + n * 16));
                            v2u w; w.x = cvt_pk_bf16(v[0], v[1]); w.y = cvt_pk_bf16(v[2], v[3]); *(v2u*)(ob + offb + bj * HALF + n * 16) = w; } }
        } else if (wc == 0) {
            const f32x4 b4 = *(const f32x4*)(bfv + 4 * fq);
            float* lf = out + (prompt ? O_LFP : O_LFS);
#pragma unroll
            for (int ai = 0; ai < 2; ++ai)
#pragma unroll
                for (int m = 0; m < 4; ++m) { const int row = row0 + ai * HALF + m * 16; const float s = sv[ai * 4 + m];
                    f32x4 o;
#pragma unroll
                    for (int j = 0; j < 4; ++j) { const float z = acc[ai][0][m][0][j] * s + b4[j]; o[j] = fminf(z, 0.f) - log1pf(__expf(-fabsf(z))); }
                    *(f32x4*)(lf + (size_t)(prompt ? row : row - TP) * NH + 4 * fq) = o; }
        }
    }
};

struct EpiQG {
    static constexpr bool PERM = true;
    static __device__ __forceinline__ int acol(const Unit&) { return 0; }
    bf16_t* Q; bf16_t* SG; const float* ss;
    __device__ __forceinline__ void operator()(const f32x4 (&acc)[2][2][4][2], const Unit& u, int wr, int wc, int fr, int fq) const {
        const bool isg = u.pn >= 8; const int row0 = u.pm * BM + wr * 64 + fr, col0 = (u.pn & 7) * BM + wc * 32 + 8 * fq; bf16_t* dst = isg ? SG : Q;
        float sv[8]; row_scales(ss, row0, sv);
#pragma unroll
        for (int ai = 0; ai < 2; ++ai)
#pragma unroll
            for (int m = 0; m < 4; ++m) { const int row = row0 + ai * HALF + m * 16; const float s = sv[ai * 4 + m], sL = s * -1.4426950408889634f;
#pragma unroll
                for (int bj = 0; bj < 2; ++bj) { f32x2 o[4];
#pragma unroll
                    for (int n = 0; n < 2; ++n) { const f32x4 a4 = acc[ai][bj][m][n]; const f32x2 a0 = {a4[0], a4[1]}, a1 = {a4[2], a4[3]};
                        if (isg) { o[2 * n] = sigmoid_scaled_pk(a0, sL); o[2 * n + 1] = sigmoid_scaled_pk(a1, sL); } else { o[2 * n] = a0 * s; o[2 * n + 1] = a1 * s; } }
                    v4u w; w.x = cvt_pk_bf16(o[0].x, o[0].y); w.y = cvt_pk_bf16(o[1].x, o[1].y); w.z = cvt_pk_bf16(o[2].x, o[2].y); w.w = cvt_pk_bf16(o[3].x, o[3].y);
                    *(v4u*)(dst + (size_t)row * DM + col0 + bj * HALF) = w; } }
    }
};
}

namespace fox {
constexpr int D = 128, NW = 8, QBLK = 32, KVBLK = 64, QB = NW * QBLK, PITCH = DM;
constexpr int SHM_V = KVBLK * D * 2, SHM_K = KVBLK * D * 2;
constexpr int NSTG = 4, OFF_K = NSTG * SHM_V, OFF_OST_S = 2 * SHM_V, OFF_WS = 132096, OFF_CB = OFF_WS + NW * 64 * 4, OFF_QP = 135168, OFF_U = OFF_QP + NW * 2048, LDS_BYTES = OFF_U + NW * 256;
static_assert(OFF_K + NSTG * SHM_K == 131072 && OFF_CB + NSTG * 256 <= OFF_QP, "attention LDS map");
constexpr float SCALE = ATT_SCALE, THR = 8.f;

#define KSWZ(row, colB) ((row) * 256 + ((colB) ^ (((row) & 7) << 4)))
#define SBAR() __builtin_amdgcn_sched_barrier(0)
__device__ __forceinline__ int v_st(int k, int c) { const int kk = (k & ~0xC) | ((k & 4) << 1) | ((k & 8) >> 1); return ((kk >> 3) * 4 + (c >> 5)) * 512 + ((kk & 7) * 32 + (c & 31)) * 2; }
__device__ __forceinline__ int v_rd_base(int lane) { return ((lane & 3) << 3) | (((lane >> 2) & 3) << 6) | (((lane >> 4) & 1) << 5) | (((lane >> 5) & 1) << 8); }
constexpr int v_rd_off(int d0, int ks, int half) { return d0 * 512 + ks * 4096 + half * 2048; }
__device__ __forceinline__ int crow(int r, int hi) { return (r & 3) + 8 * (r >> 2) + 4 * hi; }
__device__ __forceinline__ bf16x8 load8(const bf16* p) { return *reinterpret_cast<const bf16x8*>(p); }

__device__ __forceinline__ void mask_tile(f32x16& p0, f32x16& p1, int dq) {
    const float NEG = -__builtin_inff();
#pragma unroll
    for (int r = 0; r < 16; ++r) {
        const int c = (r & 3) + 8 * (r >> 2);
        if (dq - c < 0) p0[r] = NEG;
        if (dq - c - 32 < 0) p1[r] = NEG;
    }
}
__device__ __forceinline__ void partialSM(f32x16& p0, f32x16& p1, float& m_reg, float& mn, float& alpha) {
    float pmax = p0[0]; for (int r = 1; r < 16; ++r) pmax = fmaxf(pmax, p0[r]); for (int r = 0; r < 16; ++r) pmax = fmaxf(pmax, p1[r]);
    { auto rr = __builtin_amdgcn_permlane32_swap(__float_as_uint(pmax), __float_as_uint(pmax), false, false);
      pmax = fmaxf(__uint_as_float(rr[0]), __uint_as_float(rr[1])); }
    constexpr float C2 = 1.4426950408889634f * SCALE;
    if (__builtin_expect(__all((pmax - m_reg) * SCALE <= THR), 1)) { mn = m_reg; alpha = 1.f; }
    else { mn = fmaxf(m_reg, pmax); alpha = __builtin_amdgcn_exp2f((m_reg - mn) * C2); m_reg = mn; }
    const float mnL = -mn * C2;
    for (int r = 0; r < 16; ++r) p0[r] = fmaf(p0[r], C2, mnL); for (int r = 0; r < 16; ++r) p1[r] = fmaf(p1[r], C2, mnL);
    for (int r = 0; r < 16; ++r) p0[r] = __builtin_amdgcn_exp2f(p0[r]);
}
__device__ __forceinline__ void partialSM_z(f32x16& p0, f32x16& p1, float& m_reg, float& mn, float& alpha, bool& sk) {
    float pmax = p0[0]; for (int r = 1; r < 16; ++r) pmax = fmaxf(pmax, p0[r]); for (int r = 0; r < 16; ++r) pmax = fmaxf(pmax, p1[r]);
    { auto rr = __builtin_amdgcn_permlane32_swap(__float_as_uint(pmax), __float_as_uint(pmax), false, false);
      pmax = fmaxf(__uint_as_float(rr[0]), __uint_as_float(rr[1])); }
    constexpr float C2 = 1.4426950408889634f * SCALE;
    sk = __all((pmax - m_reg) * C2 < -128.f);
    if (sk) { mn = m_reg; alpha = 1.f; return; }
    if (__builtin_expect(__all((pmax - m_reg) * SCALE <= THR), 1)) { mn = m_reg; alpha = 1.f; }
    else { mn = fmaxf(m_reg, pmax); alpha = __builtin_amdgcn_exp2f((m_reg - mn) * C2); m_reg = mn; }
    const float mnL = -mn * C2;
    for (int r = 0; r < 16; ++r) p0[r] = fmaf(p0[r], C2, mnL); for (int r = 0; r < 16; ++r) p1[r] = fmaf(p1[r], C2, mnL);
    for (int r = 0; r < 16; ++r) p0[r] = __builtin_amdgcn_exp2f(p0[r]);
}
__device__ __forceinline__ void finishSM(f32x16& p0, f32x16& p1, float alpha, float& l_reg, bf16x8& pa0, bf16x8& pa1, bf16x8& pa2, bf16x8& pa3) {
    for (int r = 0; r < 16; ++r) p1[r] = __builtin_amdgcn_exp2f(p1[r]);
    float ps = 0; for (int r = 0; r < 16; ++r) ps += p0[r]; for (int r = 0; r < 16; ++r) ps += p1[r];
    { auto rr = __builtin_amdgcn_permlane32_swap(__float_as_uint(ps), __float_as_uint(ps), false, false);
      ps = __uint_as_float(rr[0]) + __uint_as_float(rr[1]); }
    l_reg = l_reg * alpha + ps;
#define PK4(P, B_, OUT) do { unsigned a0 = cvt_pk_bf16(P[B_+0], P[B_+1]), a1 = cvt_pk_bf16(P[B_+2], P[B_+3]);                          \
        unsigned b0 = cvt_pk_bf16(P[B_+4], P[B_+5]), b1 = cvt_pk_bf16(P[B_+6], P[B_+7]);                                             \
        auto r0 = __builtin_amdgcn_permlane32_swap(a0, b0, false, false); auto r1 = __builtin_amdgcn_permlane32_swap(a1, b1, false, false); \
        v4u w = {r0[0], r1[0], r0[1], r1[1]}; OUT = *reinterpret_cast<bf16x8*>(&w); } while (0)
    PK4(p0, 0, pa0); PK4(p0, 8, pa1); PK4(p1, 0, pa2); PK4(p1, 8, pa3);
#undef PK4
}
template <int KB>
__device__ __forceinline__ void qkt(f32x16& p0, f32x16& p1, const char* K_lds, const char* cb_lds, int r32, int hi, const bf16x8* qr, const char* qpl) {
    const char* cbp = cb_lds + KB * 256 + hi * 16;
#pragma unroll
    for (int g = 0; g < 4; ++g) { const f32x4 c0 = *reinterpret_cast<const f32x4*>(cbp + g * 32), c1 = *reinterpret_cast<const f32x4*>(cbp + 128 + g * 32);
#pragma unroll
        for (int j = 0; j < 4; ++j) { p0[4 * g + j] = c0[j]; p1[4 * g + j] = c1[j]; } }
    const char* kb[4];
#pragma unroll
    for (int dd = 0; dd < 4; ++dd) kb[dd] = K_lds + KB * SHM_K + KSWZ(r32, (dd * 16 + hi * 8) * 2);
#pragma unroll
    for (int d0 = 0; d0 < 8; ++d0) { const char* a = kb[d0 & 3] + (d0 >> 2) * 128;
        bf16x8 b0 = *reinterpret_cast<const bf16x8*>(a);
        bf16x8 b1 = *reinterpret_cast<const bf16x8*>(a + 32 * 256);
        const bf16x8 q = d0 < 6 ? qr[d0] : *reinterpret_cast<const bf16x8*>(qpl + (d0 - 6) * 1024);
        p0 = __builtin_amdgcn_mfma_f32_32x32x16_bf16(b0, q, p0, 0, 0, 0);
        p1 = __builtin_amdgcn_mfma_f32_32x32x16_bf16(b1, q, p1, 0, 0, 0); }
}
template <int VB>
__device__ __forceinline__ void pv_tile(f32x16* o, int vb0, bf16x8 pa0, bf16x8 pa1, bf16x8 pa2, bf16x8 pa3) {
#define TRRD(dst, off) asm volatile("ds_read_b64_tr_b16 %0, %1 offset:%2" : "=&v"(dst) : "v"(vb0), "i"(off) : "memory")
#define PV_D0(d0) do { s16x4 l0, l1, l2, l3, h0, h1, h2, h3; constexpr int b_ = VB * SHM_V + v_rd_off(d0, 0, 0); \
        TRRD(l0, b_); TRRD(h0, b_ + 2048); TRRD(l1, b_ + 4096); TRRD(h1, b_ + 6144); TRRD(l2, b_ + 8192); TRRD(h2, b_ + 10240); TRRD(l3, b_ + 12288); TRRD(h3, b_ + 14336); \
        asm volatile("s_waitcnt lgkmcnt(0)" ::: "memory"); SBAR();   \
        o[d0] = __builtin_amdgcn_mfma_f32_32x32x16_bf16(pa0, (bf16x8){l0[0], l0[1], l0[2], l0[3], h0[0], h0[1], h0[2], h0[3]}, o[d0], 0, 0, 0);   \
        o[d0] = __builtin_amdgcn_mfma_f32_32x32x16_bf16(pa1, (bf16x8){l1[0], l1[1], l1[2], l1[3], h1[0], h1[1], h1[2], h1[3]}, o[d0], 0, 0, 0);   \
        o[d0] = __builtin_amdgcn_mfma_f32_32x32x16_bf16(pa2, (bf16x8){l2[0], l2[1], l2[2], l2[3], h2[0], h2[1], h2[2], h2[3]}, o[d0], 0, 0, 0);   \
        o[d0] = __builtin_amdgcn_mfma_f32_32x32x16_bf16(pa3, (bf16x8){l3[0], l3[1], l3[2], l3[3], h3[0], h3[1], h3[2], h3[3]}, o[d0], 0, 0, 0); } while (0)
    PV_D0(0); PV_D0(1); PV_D0(2); PV_D0(3);
#undef PV_D0
#undef TRRD
}

struct BlockRef { unsigned qo, ko, co; int P0, smp; };
#define BR_NROWS(r) ((r).smp ? SS : 256)
#define BR_SKV(r) ((r).smp ? SKS : SP)
#define BR_Q(r) ((const bf16*)(ws + WS_Q) + (r).qo)
#define BR_O(r) ((bf16*)(ws + WS_Q) + (r).qo)
#define BR_G(r) ((const bf16*)(ws + WS_SG) + (r).qo)
#define BR_K(r) ((const bf16*)(ws + ((r).smp ? WS_KS : WS_KP)) + (r).ko)
#define BR_V(r) ((const bf16*)(ws + ((r).smp ? WS_VS : WS_VP)) + (r).ko)
#define BR_C(r) ((const float*)(ws + ((r).smp ? WS_CS : WS_CP)) + (r).co)
__device__ __forceinline__ int br_nt(const BlockRef& r) { int j = (r.P0 + QB - 1) / KVBLK + 1; const int m = BR_SKV(r) / KVBLK; return j > m ? m : j; }
struct Seam { bf16x8 qr[6]; bf16x8 qp0, qp1; };

#define ROW(p, k0, rr) ((p) + (size_t)((k0) + (rr)) * PITCH + sc)
#define VMW() asm volatile("s_waitcnt vmcnt(0)" ::: "memory")
#define VMWN(n) asm volatile("s_waitcnt vmcnt(%0)" :: "i"(n) : "memory")
#define DMA_IDX() const int sr = tid >> 4, kcs = ((tid & 15) ^ (sr & 7)) * 8;                                                          \
                  const int vkk = ((tid >> 7) << 3) | ((tid >> 2) & 7), vk = (vkk & ~0xC) | ((vkk & 4) << 1) | ((vkk & 8) >> 1), vc = ((tid >> 5) & 3) * 32 + (tid & 3) * 8
#define DMA_K(Kp, Cp, kbase, sg) do { const bf16* kp_ = (Kp) + (size_t)((kbase) + sr) * PITCH + kcs; PG8_LAS unsigned char* kd_ = l3 + OFF_K + (sg) * SHM_K + wid * 1024; \
        __builtin_amdgcn_global_load_lds((const unsigned*)kp_, (PG8_LAS unsigned*)kd_, 16, 0, 0);                                       \
        __builtin_amdgcn_global_load_lds((const unsigned*)(kp_ + (size_t)32 * PITCH), (PG8_LAS unsigned*)(kd_ + 8192), 16, 0, 0);       \
        __builtin_amdgcn_global_load_lds((const unsigned*)((Cp) + (kbase) + lane), (PG8_LAS unsigned*)(l3 + OFF_CB + (sg) * 256), 4, 0, 0); } while (0)
#define DMA_V(Vp, kbase, sg) do { const bf16* vp_ = (Vp) + (size_t)((kbase) + vk) * PITCH + vc; PG8_LAS unsigned char* vd_ = l3 + (sg) * SHM_V + wid * 1024; \
        __builtin_amdgcn_global_load_lds((const unsigned*)vp_, (PG8_LAS unsigned*)vd_, 16, 0, 0);                                       \
        __builtin_amdgcn_global_load_lds((const unsigned*)(vp_ + (size_t)32 * PITCH), (PG8_LAS unsigned*)(vd_ + 8192), 16, 0, 0); } while (0)
#define STEP_SYNC() asm volatile("s_waitcnt vmcnt(10) lgkmcnt(0)\n\ts_barrier" ::: "memory")

#define SQ8(W) (bf_lo(W.x) * bf_lo(W.x) + bf_hi(W.x) * bf_hi(W.x) + bf_lo(W.y) * bf_lo(W.y) + bf_hi(W.y) * bf_hi(W.y) + bf_lo(W.z) * bf_lo(W.z) + bf_hi(W.z) * bf_hi(W.z) + bf_lo(W.w) * bf_lo(W.w) + bf_hi(W.w) * bf_hi(W.w))
#define U_TABLE(BR) do { const int nt_ = br_nt(BR); float qs = 0.f;                                                                     \
        _Pragma("unroll") for (int d0 = 0; d0 < 6; ++d0) { const v4u w = *reinterpret_cast<const v4u*>(&S.qr[d0]); qs += SQ8(w); }      \
        { const v4u w = *reinterpret_cast<const v4u*>(&S.qp0); qs += SQ8(w); } { const v4u w = *reinterpret_cast<const v4u*>(&S.qp1); qs += SQ8(w); } \
        { auto rr = __builtin_amdgcn_permlane32_swap(__float_as_uint(qs), __float_as_uint(qs), false, false); qs = __uint_as_float(rr[0]) + __uint_as_float(rr[1]); } \
        float qn = __builtin_sqrtf(qs);                                                                                                  \
        _Pragma("unroll") for (int o_ = 32; o_ >= 1; o_ >>= 1) qn = fmaxf(qn, __shfl_xor(qn, o_));                                       \
        float kp = lane < nt_ ? ((const float*)(ws + WS_KMX))[((BR).co / SP) * 64 + lane] : 0.f;                                         \
        _Pragma("unroll") for (int o_ = 1; o_ < 64; o_ <<= 1) { const float v_ = __shfl_up(kp, o_); if (lane >= o_) kp = fmaxf(kp, v_); } \
        const float cbl = lane < nt_ ? ((const float*)(ws + WS_CP) + (BR).co)[lane * KVBLK + KVBLK - 1] : 0.f;                                                         \
        *(float*)(lds + OFF_U + wid * 256 + lane * 4) = qn * kp * 1.0001f + cbl; } while (0)
__device__ __forceinline__ void fox_prime(unsigned char* ws, const BlockRef& cur, char* lds, PG8_LAS unsigned char* l3, Seam& S, const int wid) {
    const int lane = lane_id_v(), tid = wid * 64 + lane, r32 = lane & 31, hi = lane >> 5;
    DMA_IDX();
    const int NT = br_nt(cur);
    DMA_K(BR_K(cur), BR_C(cur), (NT - 1) * KVBLK, 0); DMA_K(BR_K(cur), BR_C(cur), (NT - 2) * KVBLK, 1); DMA_K(BR_K(cur), BR_C(cur), (NT - 3) * KVBLK, 2);
    DMA_V(BR_V(cur), (NT - 1) * KVBLK, 0); DMA_V(BR_V(cur), (NT - 2) * KVBLK, 1);
    int qrow = wid * QBLK + r32; if (qrow > BR_NROWS(cur) - 1) qrow = BR_NROWS(cur) - 1;
    for (int d0 = 0; d0 < 6; ++d0) S.qr[d0] = load8(BR_Q(cur) + (size_t)qrow * PITCH + d0 * 16 + hi * 8);
    S.qp0 = load8(BR_Q(cur) + (size_t)qrow * PITCH + 6 * 16 + hi * 8); S.qp1 = load8(BR_Q(cur) + (size_t)qrow * PITCH + 7 * 16 + hi * 8);
    { char* qpw = lds + OFF_QP + wid * 2048 + lane * 16; *(bf16x8*)qpw = S.qp0; *(bf16x8*)(qpw + 1024) = S.qp1; }
    U_TABLE(cur);
    VMW();
    __syncthreads();
}
__device__ __forceinline__ void fox_block(unsigned char* ws, const BlockRef& cur, const BlockRef& nxt, char* lds, PG8_LAS unsigned char* l3, Seam& S, int& stg, const int wid, const int lane) {
    const int tid = wid * 64 + lane, r32 = lane & 31, hi = lane >> 5;
    const int NT = br_nt(cur), NTn = br_nt(nxt);
    const int qlo = cur.P0 + wid * QBLK, qm = qlo + r32 - 4 * hi;
    char* V_lds = lds; char* K_lds = lds + OFF_K; char* cb_lds = lds + OFF_CB;
    float* wsc = (float*)(lds + OFF_WS) + wid * 64; float* li_l = wsc, * al_l = wsc + 32;
    float m_reg = -1e30f, l_reg = 0; f32x16 o[4] = {};
    DMA_IDX();
    const int vb0 = (int)(uintptr_t)V_lds + v_rd_base(lane);
    const char* qpl = lds + OFF_QP + wid * 2048 + lane * 16;
    const unsigned cko = cur.ko, cco = cur.co, nko = nxt.ko, nco = nxt.co;
#define RESC(a) do { if (__any((a) < 1.f)) { if (hi == 0) al_l[r32] = (a); asm volatile("s_waitcnt lgkmcnt(0)" ::: "memory");              \
                     for (int d_ = 0; d_ < 4; ++d_) for (int r = 0; r < 16; ++r) o[d_][r] *= al_l[crow(r, hi)]; } } while (0)
#define KBASE(t) ((NT - 1 - (t)) * KVBLK)
#define MASKT(P0_, P1_, t) do { const int kb_ = KBASE(t); if (kb_ + KVBLK - 1 > qlo) mask_tile(P0_, P1_, qm - kb_); } while (0)
#define ISSUE(t) do { const int tk_ = (t) + 3, tv_ = (t) + 2; const bool kn_ = tk_ >= NTe, vn_ = tv_ >= NTe;                              \
        const int kbk_ = kn_ ? (NTn - 1 - (tk_ - NTe)) * KVBLK : KBASE(tk_), kbv_ = vn_ ? (NTn - 1 - (tv_ - NTe)) * KVBLK : KBASE(tv_);    \
        const unsigned kok_ = kn_ ? nko : cko, cok_ = kn_ ? nco : cco, kov_ = vn_ ? nko : cko;                                        \
        DMA_K((const bf16*)(ws + WS_KP) + kok_, (const float*)(ws + WS_CP) + cok_, kbk_, (s0 + 3) & 3); DMA_V((const bf16*)(ws + WS_VP) + kov_, kbv_, (s0 + 2) & 3); } while (0)
    f32x16 pA0, pA1, pB0, pB1; float mnA, mnB, alA, alB; bf16x8 pa0, pa1, pa2, pa3; bool skA = false, skB = false;
    const bool act = wid * QBLK < BR_NROWS(cur);
    int s0 = stg;
    int NTe = NT;
    ISSUE(0);
    SBAR(); if (act) { qkt<0>(pA0, pA1, K_lds + s0 * SHM_K, cb_lds + s0 * 256, r32, hi, S.qr, qpl);
    MASKT(pA0, pA1, 0); partialSM_z(pA0, pA1, m_reg, mnA, alA, skA); }
    STEP_SYNC(); s0 = (s0 + 1) & 3;
#define HALF_STEP(PX0, PX1, mnX, alX, skX, PY0, PY1, alY, skY, t) do {                                                          \
        ISSUE(t);                                                                                                                 \
        SBAR(); if (act) { qkt<0>(PX0, PX1, K_lds + s0 * SHM_K, cb_lds + s0 * 256, r32, hi, S.qr, qpl);                           \
        if (!skY) finishSM(PY0, PY1, alY, l_reg, pa0, pa1, pa2, pa3); } SBAR();                                                   \
        if (act) { if (!skY) pv_tile<0>(o, vb0 + ((s0 + 3) & 3) * SHM_V, pa0, pa1, pa2, pa3); MASKT(PX0, PX1, (t)); partialSM_z(PX0, PX1, m_reg, mnX, alX, skX); \
                   RESC(alX); }                                                                                                   \
        STEP_SYNC(); s0 = (s0 + 1) & 3; } while (0)
    int t = 1;
    if (NT > 8) {
#pragma unroll 1
        for (; t < 5; t += 2) {
            HALF_STEP(pB0, pB1, mnB, alB, skB, pA0, pA1, alA, skA, t);
            HALF_STEP(pA0, pA1, mnA, alA, skA, pB0, pB1, alB, skB, t + 1);
        }
        float mm = m_reg;
#pragma unroll
        for (int o_ = 32; o_ >= 1; o_ >>= 1) mm = fminf(mm, __shfl_xor(mm, o_));
        const float u_ = *(const float*)(lds + OFF_U + wid * 256 + lane * 4);
        const bool ok_ = lane < NT && (u_ - mm) * (1.4426950408889634f * SCALE) < -130.f;
        const unsigned long long bal_ = __ballot(ok_);
        const int f_ = bal_ == ~0ull ? 64 : __builtin_ctzll(~bal_);
        if (lane == 0) *(int*)li_l = NT - f_;
        asm volatile("s_waitcnt lgkmcnt(0)\n\ts_barrier" ::: "memory");
        int need_ = 0;
#pragma unroll
        for (int w_ = 0; w_ < NW; ++w_) { const int v_ = *(const int*)(lds + OFF_WS + w_ * 256); need_ = v_ > need_ ? v_ : need_; }
        need_ = __builtin_amdgcn_readfirstlane(need_); need_ = (need_ + 1) & ~1; if (need_ < 8) need_ = 8; if (need_ < NTe) NTe = need_;
    }
#pragma unroll 1
    for (; t + 1 < NTe; t += 2) {
        HALF_STEP(pB0, pB1, mnB, alB, skB, pA0, pA1, alA, skA, t);
        HALF_STEP(pA0, pA1, mnA, alA, skA, pB0, pB1, alB, skB, t + 1);
    }
    HALF_STEP(pB0, pB1, mnB, alB, skB, pA0, pA1, alA, skA, NTe - 1);
    int qrow_n = wid * QBLK + r32; if (qrow_n > BR_NROWS(nxt) - 1) qrow_n = BR_NROWS(nxt) - 1;
#pragma unroll
    for (int d0 = 0; d0 < 6; ++d0) S.qr[d0] = load8(BR_Q(nxt) + (size_t)qrow_n * PITCH + d0 * 16 + hi * 8);
    S.qp0 = load8(BR_Q(nxt) + (size_t)qrow_n * PITCH + 6 * 16 + hi * 8); S.qp1 = load8(BR_Q(nxt) + (size_t)qrow_n * PITCH + 7 * 16 + hi * 8);
    SBAR();
    if (act && !skB) { finishSM(pB0, pB1, alB, l_reg, pa0, pa1, pa2, pa3); SBAR(); pv_tile<0>(o, vb0 + ((s0 + 3) & 3) * SHM_V, pa0, pa1, pa2, pa3); }
    stg = s0;
    const int ost_off = wid < 4 ? OFF_K + ((s0 + 3) & 3) * SHM_K + wid * 4096 : ((s0 + 2) & 3) * SHM_V + (wid - 4) * 4096;
    SBAR();
    if (hi == 0) li_l[r32] = l_reg; asm volatile("s_waitcnt lgkmcnt(0)" ::: "memory");
    if (act) {
        int lane_e = lane, wid_e = wid; asm volatile("" : "+v"(lane_e), "+s"(wid_e));
        const int r32_e = lane_e & 31, hi_e = lane_e >> 5;
        const float* li_e = (const float*)(lds + OFF_WS) + wid_e * 64 + 4 * hi_e;
        float rli[16];
#pragma unroll
        for (int r = 0; r < 16; ++r) rli[r] = __builtin_amdgcn_rcpf(li_e[(r & 3) + 8 * (r >> 2)]);
        int ost_e = ost_off; asm volatile("" : "+s"(ost_e));
        bf16* stg = (bf16*)(lds + ost_e);
        bf16* stw = stg + 4 * hi_e * 64 + r32_e;
        const size_t lo_ = (size_t)(wid_e * QBLK + (lane_e >> 3)) * PITCH + (lane_e & 7) * 8;
        bf16* Ow = BR_O(cur) + lo_; const bf16* Gw = BR_G(cur) + lo_;
        const bf16* str = stg + (lane_e >> 3) * 64 + (lane_e & 7) * 8;
        v4u gqa[2][4];
#pragma unroll
        for (int hf = 0; hf < 2; ++hf)
#pragma unroll
            for (int i = 0; i < 4; ++i) gqa[hf][i] = *(const v4u*)(Gw + (size_t)i * 8 * PITCH + hf * 64);
#pragma unroll
        for (int hf = 0; hf < 2; ++hf) {
#pragma unroll
            for (int r = 0; r < 16; ++r) {
#pragma unroll
                for (int d0 = 0; d0 < 2; ++d0) stw[((r & 3) + 8 * (r >> 2)) * 64 + d0 * 32] = (bf16)(cvt_pk_bf16(o[2 * hf + d0][r] * rli[r], 0.f) & 0xffffu); }
            asm volatile("s_waitcnt lgkmcnt(0)" ::: "memory");
#pragma unroll
            for (int i = 0; i < 4; ++i) { const v4u v = *(const v4u*)(str + i * 8 * 64); const v4u gg = gqa[hf][i];
                v4u w; w.x = cvt_pk_bf16(bf_lo(v.x) * bf_lo(gg.x), bf_hi(v.x) * bf_hi(gg.x)); w.y = cvt_pk_bf16(bf_lo(v.y) * bf_lo(gg.y), bf_hi(v.y) * bf_hi(gg.y));
                w.z = cvt_pk_bf16(bf_lo(v.z) * bf_lo(gg.z), bf_hi(v.z) * bf_hi(gg.z)); w.w = cvt_pk_bf16(bf_lo(v.w) * bf_lo(gg.w), bf_hi(v.w) * bf_hi(gg.w));
                *(v4u*)(Ow + (size_t)i * 8 * PITCH + hf * 64) = w; }
            asm volatile("s_waitcnt lgkmcnt(0)" ::: "memory");
        }
    }
    U_TABLE(nxt);
    { char* qpw = lds + OFF_QP + wid * 2048 + lane * 16; *(bf16x8*)qpw = S.qp0; *(bf16x8*)(qpw + 1024) = S.qp1; }
    __syncthreads();
#undef RESC
#undef KBASE
#undef MASKT
#undef ISSUE
#undef HALF_STEP
}
__device__ __forceinline__ void fox_sample(unsigned char* ws, const float* cache_k, const float* cache_v, const int b, const int h, char* lds, const int wid, const int lane) {
    const int tid = wid * 64 + lane, r32 = lane & 31, hi = lane >> 5;
    char* V_lds = lds; char* K_lds = lds + OFF_K; char* cb_lds = lds + OFF_CB;
    constexpr int NT = SKS / KVBLK;
    const float* Cs = (const float*)(ws + WS_CS) + (size_t)(b * NH + h) * SKS;
    if (wid >= 2) {
        if (wid < 6) {
            const int lt = tid - 128, sr = lt >> 4, sc = (lt & 15) * 8;
            const float* kc = cache_k + ((size_t)b * PAST * DM + h * HD + sc); const float* vc = cache_v + ((size_t)b * PAST * DM + h * HD + sc);
            const bf16* kn = (const bf16*)(ws + WS_KS) + ((size_t)b * SS * DM + h * HD + sc); const bf16* vn = (const bf16*)(ws + WS_VS) + ((size_t)b * SS * DM + h * HD + sc);
            f32x4 kf[4][2], vf[4][2]; bf16x8 kh[4], vh[4]; float cv = 0.f;
#define SMP_LOAD(t) do { if ((t) < NT - 1) { _Pragma("unroll") for (int j = 0; j < 4; ++j) { const size_t ro = (size_t)((t) * KVBLK + sr + 16 * j) * DM; \
                kf[j][0] = *(const f32x4*)(kc + ro); kf[j][1] = *(const f32x4*)(kc + ro + 4); vf[j][0] = *(const f32x4*)(vc + ro); vf[j][1] = *(const f32x4*)(vc + ro + 4); } } \
            else { _Pragma("unroll") for (int j = 0; j < 4; ++j) { const size_t ro = (size_t)(sr + 16 * j) * DM; kh[j] = *(const bf16x8*)(kn + ro); vh[j] = *(const bf16x8*)(vn + ro); } } \
            if (lt < 64) cv = Cs[(t) * KVBLK + lt]; } while (0)
#define SMP_WRITE(t) do { const int bf_ = (t) & 1; _Pragma("unroll") for (int j = 0; j < 4; ++j) { const int R = sr + 16 * j; bf16x8 kk, vv; \
                if ((t) < NT - 1) { v4u a_ = {cvt_pk_bf16(kf[j][0][0], kf[j][0][1]), cvt_pk_bf16(kf[j][0][2], kf[j][0][3]), cvt_pk_bf16(kf[j][1][0], kf[j][1][1]), cvt_pk_bf16(kf[j][1][2], kf[j][1][3])}; kk = *reinterpret_cast<bf16x8*>(&a_); \
                    v4u b_ = {cvt_pk_bf16(vf[j][0][0], vf[j][0][1]), cvt_pk_bf16(vf[j][0][2], vf[j][0][3]), cvt_pk_bf16(vf[j][1][0], vf[j][1][1]), cvt_pk_bf16(vf[j][1][2], vf[j][1][3])}; vv = *reinterpret_cast<bf16x8*>(&b_); } \
                else { kk = kh[j]; vv = vh[j]; } \
                *(bf16x8*)(K_lds + bf_ * SHM_K + KSWZ(R, sc * 2)) = kk; *(bf16x8*)(V_lds + bf_ * SHM_V + v_st(R, sc)) = vv; } \
            if (lt < 64) *(float*)(cb_lds + bf_ * 256 + lt * 4) = cv; } while (0)
            SMP_LOAD(0); SMP_WRITE(0);
            __syncthreads();
            for (int t = 0; t < NT; ++t) {
                if (t + 1 < NT) SMP_LOAD(t + 1);
                __syncthreads();
                if (t + 1 < NT) SMP_WRITE(t + 1);
                __syncthreads();
            }
#undef SMP_LOAD
#undef SMP_WRITE
        } else {
            __syncthreads();
            for (int t = 0; t < NT; ++t) { __syncthreads(); __syncthreads(); }
        }
        return;
    }
    float* wsc = (float*)(lds + OFF_WS) + wid * 64; float* li_l = wsc, * al_l = wsc + 32;
    const size_t qo = ((size_t)TP + (size_t)b * SS) * DM + h * HD;
    bf16x8 qr[8];
#pragma unroll
    for (int d0 = 0; d0 < 8; ++d0) qr[d0] = load8((const bf16*)(ws + WS_Q) + qo + (size_t)(wid * QBLK + r32) * PITCH + d0 * 16 + hi * 8);
    const int vb0 = (int)(uintptr_t)V_lds + v_rd_base(lane);
    const int qm = wid * QBLK + r32 - 4 * hi;
    float m_reg = -1e30f, l_reg = 0; f32x16 o[4] = {};
    __syncthreads();
#define SMP_TILE(KB_, t) do { f32x16 p0, p1; float mn, al; bf16x8 pa0, pa1, pa2, pa3; \
        { const char* cbp = cb_lds + KB_ * 256 + hi * 16; \
          _Pragma("unroll") for (int g = 0; g < 4; ++g) { const f32x4 c0 = *reinterpret_cast<const f32x4*>(cbp + g * 32), c1 = *reinterpret_cast<const f32x4*>(cbp + 128 + g * 32); \
              _Pragma("unroll") for (int j = 0; j < 4; ++j) { p0[4 * g + j] = c0[j]; p1[4 * g + j] = c1[j]; } } \
          const char* kb[4]; _Pragma("unroll") for (int dd = 0; dd < 4; ++dd) kb[dd] = K_lds + KB_ * SHM_K + KSWZ(r32, (dd * 16 + hi * 8) * 2); \
          _Pragma("unroll") for (int d0 = 0; d0 < 8; ++d0) { const char* a = kb[d0 & 3] + (d0 >> 2) * 128; \
              const bf16x8 b0 = *reinterpret_cast<const bf16x8*>(a), b1 = *reinterpret_cast<const bf16x8*>(a + 32 * 256); \
              p0 = __builtin_amdgcn_mfma_f32_32x32x16_bf16(b0, qr[d0], p0, 0, 0, 0); p1 = __builtin_amdgcn_mfma_f32_32x32x16_bf16(b1, qr[d0], p1, 0, 0, 0); } } \
        if ((t) == NT - 1) mask_tile(p0, p1, qm); \
        partialSM(p0, p1, m_reg, mn, al); \
        if (__any(al < 1.f)) { if (hi == 0) al_l[r32] = al; asm volatile("s_waitcnt lgkmcnt(0)" ::: "memory"); \
            for (int d_ = 0; d_ < 4; ++d_) for (int r = 0; r < 16; ++r) o[d_][r] *= al_l[crow(r, hi)]; } \
        finishSM(p0, p1, al, l_reg, pa0, pa1, pa2, pa3); SBAR(); \
        pv_tile<KB_>(o, vb0, pa0, pa1, pa2, pa3); } while (0)
    for (int t = 0; t < NT; t += 2) {
        SMP_TILE(0, t);
        __syncthreads(); __syncthreads();
        if (t + 1 < NT) { SMP_TILE(1, t + 1); __syncthreads(); __syncthreads(); }
    }
#undef SMP_TILE
    if (hi == 0) li_l[r32] = l_reg; asm volatile("s_waitcnt lgkmcnt(0)" ::: "memory");
    { float rli[16];
#pragma unroll
      for (int r = 0; r < 16; ++r) rli[r] = __builtin_amdgcn_rcpf(li_l[crow(r, hi)]);
      bf16* stg = (bf16*)(lds + OFF_OST_S) + wid * 2048; bf16* stw = stg + 4 * hi * 64 + r32;
      const size_t lo_ = (size_t)(wid * QBLK + (lane >> 3)) * PITCH + (lane & 7) * 8;
      bf16* Ow = (bf16*)(ws + WS_Q) + qo + lo_; const bf16* Gw = (const bf16*)(ws + WS_SG) + qo + lo_;
      const bf16* str = stg + (lane >> 3) * 64 + (lane & 7) * 8;
      v4u gqa[2][4];
#pragma unroll
      for (int hf = 0; hf < 2; ++hf)
#pragma unroll
          for (int i = 0; i < 4; ++i) gqa[hf][i] = *(const v4u*)(Gw + (size_t)i * 8 * PITCH + hf * 64);
#pragma unroll
      for (int hf = 0; hf < 2; ++hf) {
#pragma unroll
          for (int r = 0; r < 16; ++r) {
#pragma unroll
              for (int d0 = 0; d0 < 2; ++d0) stw[((r & 3) + 8 * (r >> 2)) * 64 + d0 * 32] = (bf16)(cvt_pk_bf16(o[2 * hf + d0][r] * rli[r], 0.f) & 0xffffu); }
          asm volatile("s_waitcnt lgkmcnt(0)" ::: "memory");
#pragma unroll
          for (int i = 0; i < 4; ++i) { const v4u v = *(const v4u*)(str + i * 8 * 64); const v4u gg = gqa[hf][i];
              v4u w; w.x = cvt_pk_bf16(bf_lo(v.x) * bf_lo(gg.x), bf_hi(v.x) * bf_hi(gg.x)); w.y = cvt_pk_bf16(bf_lo(v.y) * bf_lo(gg.y), bf_hi(v.y) * bf_hi(gg.y));
              w.z = cvt_pk_bf16(bf_lo(v.z) * bf_lo(gg.z), bf_hi(v.z) * bf_hi(gg.z)); w.w = cvt_pk_bf16(bf_lo(v.w) * bf_lo(gg.w), bf_hi(v.w) * bf_hi(gg.w));
              *(v4u*)(Ow + (size_t)i * 8 * PITCH + hf * 64) = w; }
          asm volatile("s_waitcnt lgkmcnt(0)" ::: "memory");
      } }
}
#undef ROW
#undef VMW
#undef VMWN
#undef DMA_IDX
#undef SQ8
#undef U_TABLE
#undef DMA_K
#undef DMA_V
#undef STEP_SYNC
}

constexpr int RING_OFF = 0, RING_BYTES = 131072;
constexpr int LDSCTL_OFF = RING_BYTES, MISC_OFF = LDSCTL_OFF + 320;
constexpr int LDS_BYTES = 155648;
static_assert(fox::LDS_BYTES <= LDS_BYTES && fox::OFF_WS >= LDSCTL_OFF + 1024, "attention scratch: ring region + the space above the control words");

#define RLX_AGENT __ATOMIC_RELAXED, __HIP_MEMORY_SCOPE_AGENT
#define LDS_WAIT() asm volatile("s_waitcnt lgkmcnt(0)" ::: "memory")
#define VM_WAIT() asm volatile("s_waitcnt vmcnt(0)" ::: "memory")

#define XB_TMO      128
#define XB_XCNT(j)  (256  + 64 * (j))
#define XB_XSUB(j)  (1280 + 64 * (j))
#define XB_XGEN(j)  (2304 + 64 * (j))
#define XB_TOP      3328
#define XB_TOPGEN   3392
#define XCD_BAR_WORDS 3456
#define XB_SPIN_CAP (1u << 18)
__device__ __forceinline__ unsigned xb_ld(unsigned* p)              { return __hip_atomic_load(p, __ATOMIC_RELAXED, __HIP_MEMORY_SCOPE_AGENT); }
__device__ __forceinline__ unsigned xb_add(unsigned* p, unsigned v) { return __hip_atomic_fetch_add(p, v, __ATOMIC_RELAXED, __HIP_MEMORY_SCOPE_AGENT); }
__device__ __forceinline__ unsigned xb_xcc_id() { return (unsigned)__builtin_amdgcn_s_getreg((3 << 11) | 20) & 0xFu; }
#define XB_SPIN(cond, bar) do { unsigned _sp = 0; while (cond) { __builtin_amdgcn_s_sleep(1); \
    if ((++_sp & 255u) == 0u) { if (xb_ld(&(bar)[XB_TMO])) break; if (_sp > XB_SPIN_CAP) { atomicAdd(&(bar)[XB_TMO], 1u); break; } } } } while (0)
struct XcdBarrier { unsigned* bar; unsigned x; volatile LAS unsigned* st; };
__device__ __forceinline__ XcdBarrier xcd_barrier_post(unsigned* bar, volatile LAS unsigned* st) {
    XcdBarrier b; b.bar = bar; b.x = xb_xcc_id(); b.st = st;
    if (threadIdx.x == 0) (void)xb_add(&bar[XB_XCNT(b.x)], 1u);
    return b;
}
__device__ __forceinline__ void xcd_barrier_complete(unsigned* bar, unsigned x, unsigned& nloc, unsigned& nx) {
    const unsigned G = gridDim.x * gridDim.y * gridDim.z;
    unsigned sum, cnt, mine, sp = 0u;
    for (;;) {
        sum = 0u; cnt = 0u; mine = 0u;
#pragma unroll
        for (unsigned j = 0; j < 16; ++j) { const unsigned c = xb_ld(&bar[XB_XCNT(j)]); sum += c; cnt += (c > 0u) ? 1u : 0u; mine = (j == x) ? c : mine; }
        if (sum == G) break;
        __builtin_amdgcn_s_sleep(1);
        if ((++sp & 255u) == 0u) { if (xb_ld(&bar[XB_TMO])) break; if (sp > XB_SPIN_CAP) { atomicAdd(&bar[XB_TMO], 1u); break; } }
    }
    nloc = mine > 0u ? mine : 1u; nx = cnt > 0u ? cnt : 1u;
}
__device__ __forceinline__ void xcd_barrier(const XcdBarrier& b) {
    asm volatile("s_waitcnt vmcnt(0)" ::: "memory");
    __syncthreads();
    if (threadIdx.x == 0) {
        unsigned* bar = b.bar;
        __builtin_amdgcn_s_waitcnt(0);
        unsigned nloc = b.st[0], nx = b.st[1];
        if (nloc == 0u) { xcd_barrier_complete(bar, b.x, nloc, nx); b.st[0] = nloc; b.st[1] = nx; }
        const unsigned old = xb_add(&bar[XB_XSUB(b.x)], 1u);
        const unsigned gen = old / nloc;
        if (old + 1u == (gen + 1u) * nloc) {
            __builtin_amdgcn_fence(__ATOMIC_RELEASE, "agent");
            asm volatile("s_waitcnt vmcnt(0)" ::: "memory");
            const unsigned og = xb_add(&bar[XB_TOP], 1u);
            const unsigned tg = og / nx;
            if (og + 1u == (tg + 1u) * nx) xb_add(&bar[XB_TOPGEN], 1u);
            else XB_SPIN(xb_ld(&bar[XB_TOPGEN]) == tg, bar);
            __builtin_amdgcn_fence(__ATOMIC_ACQUIRE, "agent");
            xb_add(&bar[XB_XGEN(b.x)], 1u);
            asm volatile("s_waitcnt vmcnt(0)" ::: "memory");
        } else {
            XB_SPIN(xb_ld(&bar[XB_XGEN(b.x)]) == gen, bar);
            __builtin_amdgcn_fence(__ATOMIC_ACQUIRE, "agent");
            asm volatile("s_waitcnt vmcnt(0)" ::: "memory");
        }
    }
    __syncthreads();
}

__device__ __forceinline__ float wave_sum(float v) {
#pragma unroll
    for (int o = 1; o < 64; o <<= 1) v += __shfl_xor(v, o);
    return v;
}
__device__ __forceinline__ void tr_item(const float* W, int N, bf16* WT, int KP_, const float* gain, int k0, int n0, int drow0, LAS float* scr, int lane) {
#pragma unroll 8
    for (int i = 0; i < 32; ++i) { const int kk = 2 * i + (lane >> 5); scr[kk * 33 + (lane & 31)] = W[(size_t)(k0 + kk) * N + n0 + (lane & 31)]; }
    LDS_WAIT(); asm volatile("" ::: "memory");
    const int c = lane & 7;
    float gv[8];
    if (gain) { const f32x4 a = *(const f32x4*)(gain + k0 + 8 * c), b = *(const f32x4*)(gain + k0 + 8 * c + 4);
        gv[0] = a[0]; gv[1] = a[1]; gv[2] = a[2]; gv[3] = a[3]; gv[4] = b[0]; gv[5] = b[1]; gv[6] = b[2]; gv[7] = b[3]; }
    else {
#pragma unroll
        for (int i = 0; i < 8; ++i) gv[i] = 1.f; }
#pragma unroll
    for (int j = 0; j < 4; ++j) { const int n = (lane >> 3) + 8 * j; const LAS float* s = scr + (8 * c) * 33 + n;
        v4u o; o.x = cvt_pk_bf16(s[0 * 33] * gv[0], s[1 * 33] * gv[1]); o.y = cvt_pk_bf16(s[2 * 33] * gv[2], s[3 * 33] * gv[3]);
        o.z = cvt_pk_bf16(s[4 * 33] * gv[4], s[5 * 33] * gv[5]); o.w = cvt_pk_bf16(s[6 * 33] * gv[6], s[7 * 33] * gv[7]);
        *(v4u*)(WT + (size_t)(drow0 + n) * KP_ + k0 + 8 * c) = o; }
    LDS_WAIT(); asm volatile("" ::: "memory");
}
__device__ __forceinline__ void tr_matrix(const float* W, int K, int N, bf16* WT, const float* gain, int mode, int row_off, LAS float* scr, int gw, int NGW, int lane) {
    const int nblk = N / 32, nitems = (K / 64) * nblk;
    for (int it = gw; it < nitems; it += NGW) { const int kb = it / nblk, nb = it - kb * nblk, n0 = nb * 32; int drow0;
        if (mode == 1) { const int up = n0 >= DFF ? 1 : 0, j = n0 - up * DFF; drow0 = (j >> 7) * 256 + up * 128 + (j & 127); } else drow0 = row_off + n0;
        tr_item(W, N, WT, K, gain, kb * 64, n0, drow0, scr, lane); }
}

struct Args { const float* in[26]; float* out; unsigned char* ws; int ph_lo, ph_hi; };

struct Frame {
    LAS unsigned char* lds; volatile LAS unsigned* MISC;
    int wave, vcu, G;
    unsigned char* ws; float* out;
};
#define IN_(k) (args.in[k])

constexpr int TRP = 129;
struct TrTile { const float* W; const float* gain; bf16* WT; int N, K, k0, n0, drow0; };
constexpr int TT_W1 = (DM / 128) * (2 * DFF / 128), TT_W2 = (DFF / 128) * (DM / 128), TT_AIN = (DM / 128) * (2 * DR / 128), TT_WG = 20 * 4, TT_AOUT = (DR / 128) * (DM / 128),
              TT_KV = (DM / 128) * (2 * DM / 128), TT_QG = TT_KV, TT_O = (DM / 128) * (DM / 128);
constexpr int TT_E0 = 4 * TT_W1, TT_E1 = TT_E0 + 4 * TT_W2, TT_E2 = TT_E1 + TT_AIN, TT_E3 = TT_E2 + TT_WG, TT_E4 = TT_E3 + TT_AOUT, TT_E5 = TT_E4 + TT_KV, TT_E6 = TT_E5 + TT_QG, TT_TOTAL = TT_E6 + TT_O;
__device__ __forceinline__ TrTile tr_decode(const Args& args, unsigned char* ws, int t) {
    TrTile r; r.gain = nullptr; int l, mode = 0; size_t dsto;
    if (t < TT_E0)      { const int f = t / TT_W1; l = t - f * TT_W1; r.W = IN_(8) + (size_t)f * DM * 2 * DFF; r.gain = IN_(7) + (size_t)f * DM; r.K = DM; r.N = 2 * DFF; dsto = WS_W1 + (size_t)f * SZ_W1; mode = 1; }
    else if (t < TT_E1) { const int u = t - TT_E0, f = u / TT_W2; l = u - f * TT_W2; r.W = IN_(9) + (size_t)f * DFF * DM; r.K = DFF; r.N = DM; dsto = WS_W2 + (size_t)f * SZ_W2; }
    else if (t < TT_E2) { l = t - TT_E1; r.W = IN_(11); r.gain = IN_(10); r.K = DM; r.N = 2 * DR; dsto = WS_WAIN; }
    else if (t < TT_E3) { const int u = t - TT_E2, gh = u >> 2; l = u & 3; r.W = IN_(14) + (size_t)gh * 256 * 256; r.K = 256; r.N = 256; dsto = WS_WG; mode = 2 + gh; }
    else if (t < TT_E4) { l = t - TT_E3; r.W = IN_(17); r.K = DR; r.N = DM; dsto = WS_WAOUT; }
    else if (t < TT_E5) { l = t - TT_E4; r.W = IN_(19); r.gain = IN_(18); r.K = DM; r.N = 2 * DM; dsto = WS_WKV; }
    else if (t < TT_E6) { l = t - TT_E5; r.W = IN_(23); r.gain = IN_(22); r.K = DM; r.N = 2 * DM; dsto = WS_WQG; }
    else                { l = t - TT_E6; r.W = IN_(24); r.K = DM; r.N = DM; dsto = WS_WO; }
    const int nblk = r.N / 128, kb = l / nblk, nb = l - kb * nblk; r.k0 = kb * 128; r.n0 = nb * 128; r.drow0 = r.n0; r.WT = (bf16*)(ws + dsto);
    if (mode == 1) { const int up = r.n0 >= DFF ? 1 : 0, j = r.n0 - up * DFF; r.drow0 = (j >> 7) * 256 + up * 128; }
    else if (mode >= 2) { const int gh = mode - 2, g = gh / NRH, hb = gh % NRH; r.drow0 = (2 * hb + (r.n0 >> 7)) * 256 + g * 128; }
    return r;
}
__device__ __forceinline__ void convert_tiles(const Args& args, Frame& F, const int t0, const int t1, const int c0 = 0) {
    const int lane = lane_id_v(); const int t = F.wave * 64 + lane;
    unsigned char* ws = F.ws;
    LAS float* scr = (LAS float*)(F.lds + RING_OFF);
    const int lr = t >> 5, lc = (t & 31) * 4;
    const int sc = t & 15, sn = t >> 4;
    f32x4 ld[8];
    const int nc = F.G - c0; if ((int)blockIdx.x < c0) return;
    int tile = t0 + (c0 ? (int)blockIdx.x - c0 : F.vcu);
    if (tile < t1) { const TrTile q = tr_decode(args, ws, tile);
#pragma unroll
        for (int i = 0; i < 8; ++i) ld[i] = *(const f32x4*)(q.W + (size_t)(q.k0 + lr + 16 * i) * q.N + q.n0 + lc); }
    for (; tile < t1; tile += nc) {
        const TrTile q = tr_decode(args, ws, tile);
#pragma unroll
        for (int i = 0; i < 8; ++i) { LAS float* p = scr + (lr + 16 * i) * TRP + lc; p[0] = ld[i][0]; p[1] = ld[i][1]; p[2] = ld[i][2]; p[3] = ld[i][3]; }
        __syncthreads();
        if (tile + nc < t1) { const TrTile qn = tr_decode(args, ws, tile + nc);
#pragma unroll
            for (int i = 0; i < 8; ++i) ld[i] = *(const f32x4*)(qn.W + (size_t)(qn.k0 + lr + 16 * i) * qn.N + qn.n0 + lc); }
        float gv[8];
        if (q.gain) { const f32x4 a = *(const f32x4*)(q.gain + q.k0 + 8 * sc), b = *(const f32x4*)(q.gain + q.k0 + 8 * sc + 4);
            gv[0] = a[0]; gv[1] = a[1]; gv[2] = a[2]; gv[3] = a[3]; gv[4] = b[0]; gv[5] = b[1]; gv[6] = b[2]; gv[7] = b[3]; }
        else {
#pragma unroll
            for (int i = 0; i < 8; ++i) gv[i] = 1.f; }
#pragma unroll
        for (int j = 0; j < 4; ++j) { const int n = sn + 32 * j; const LAS float* sp = scr + (8 * sc) * TRP + n;
            v4u o; o.x = cvt_pk_bf16(sp[0 * TRP] * gv[0], sp[1 * TRP] * gv[1]); o.y = cvt_pk_bf16(sp[2 * TRP] * gv[2], sp[3 * TRP] * gv[3]);
            o.z = cvt_pk_bf16(sp[4 * TRP] * gv[4], sp[5 * TRP] * gv[5]); o.w = cvt_pk_bf16(sp[6 * TRP] * gv[6], sp[7 * TRP] * gv[7]);
            *(v4u*)(q.WT + (size_t)(q.drow0 + n) * q.K + q.k0 + 8 * sc) = o; }
        __syncthreads();
    }
}
__device__ __forceinline__ void p0_prologue(const Args& args, Frame& F) {
    const int lane = lane_id_v(); const int gw = F.vcu * NWAVES + F.wave, NGW = F.G * NWAVES;
    unsigned char* ws = F.ws;
    convert_tiles(args, F, 0, TT_W1);
    {
        const int gt = gw * 64 + lane, NGT = NGW * 64; bf16* WT = (bf16*)(ws + WS_WKV) + (size_t)2 * DM * DM;
        for (int i = gt; i < 256 * DM; i += NGT) { const int n = i / DM, k = i - n * DM; float v = 0.f; if (n < NH) v = IN_(20)[(size_t)k * NH + n] * IN_(18)[k];
            WT[i] = (bf16)(cvt_pk_bf16(v, 0.f) & 0xffffu); }
        float* cl = (float*)(ws + WS_CL);
        for (int i = gt; i < DR; i += NGT) cl[i] = -8.0f * log1pf(expf(-IN_(16)[i]));
    }
    { float* ssq0 = (float*)(ws + SSQ_OFF); bf16* XB = (bf16*)(ws + WS_XB);
      for (int m = gw; m < T; m += NGW) { const float* xr = (m < TP) ? IN_(0) + (size_t)m * DM : IN_(1) + (size_t)(m - TP) * DM;
        float s = 0.f;
#pragma unroll
        for (int j = 0; j < 8; ++j) { const f32x4 v = *((const f32x4*)xr + lane + 64 * j); s += (v[0] * v[0] + v[1] * v[1]) + (v[2] * v[2] + v[3] * v[3]);
            v2u w; w.x = cvt_pk_bf16(v[0], v[1]); w.y = cvt_pk_bf16(v[2], v[3]); *((v2u*)(XB + (size_t)m * DM) + lane + 64 * j) = w; }
        s = wave_sum(s); if (lane == 0) ssq0[m] = s; } }
}

__device__ __forceinline__ void conv_phase(const Args& args, Frame& F) {
    const bf16* U = (const bf16*)(F.ws + WS_U); bf16* UC = (bf16*)(F.ws + WS_UC);
    const float* cw = IN_(12); const float* cb = IN_(13); const float* stc = IN_(2);
    const int gt = (F.vcu * NWAVES + F.wave) * 64 + lane_id_v(), NGT = F.G * NWAVES * 64;
    constexpr int CG = DR / 8, CH = 32;
    constexpr int NIT = (T / CH) * CG;
    for (int it = gt; it < NIT; it += NGT) {
        const int cg = it % CG, chunk = it / CG, c0 = cg * 8, row0 = chunk * CH;
        const bool prompt = row0 < TP; const int t0 = prompt ? (row0 & (SP - 1)) : ((row0 - TP) & (SS - 1)); const int slen = prompt ? SP : SS;
        float w[4][8], bb[8], h[3][8];
#pragma unroll
        for (int k = 0; k < 4; ++k) { const f32x4 a = *(const f32x4*)(cw + k * DR + c0), b = *(const f32x4*)(cw + k * DR + c0 + 4);
#pragma unroll
            for (int j = 0; j < 4; ++j) { w[k][j] = a[j]; w[k][4 + j] = b[j]; } }
        { const f32x4 a = *(const f32x4*)(cb + c0), b = *(const f32x4*)(cb + c0 + 4);
#pragma unroll
            for (int j = 0; j < 4; ++j) { bb[j] = a[j]; bb[4 + j] = b[j]; } }
        if (t0 == 0) {
            if (prompt) {
#pragma unroll
                for (int k = 0; k < 3; ++k)
#pragma unroll
                    for (int j = 0; j < 8; ++j) h[k][j] = 0.f; }
            else { const int b = (row0 - TP) / SS;
#pragma unroll
                for (int k = 0; k < 3; ++k) { const f32x4 a = *(const f32x4*)(stc + ((size_t)b * 3 + k) * DR + c0), bq = *(const f32x4*)(stc + ((size_t)b * 3 + k) * DR + c0 + 4);
#pragma unroll
                    for (int j = 0; j < 4; ++j) { h[k][j] = a[j]; h[k][4 + j] = bq[j]; } } }
        } else {
#pragma unroll
            for (int k = 0; k < 3; ++k) { const v4u q = *(const v4u*)(U + (size_t)(row0 - 3 + k) * DR + c0);
                h[k][0] = bf_lo(q.x); h[k][1] = bf_hi(q.x); h[k][2] = bf_lo(q.y); h[k][3] = bf_hi(q.y); h[k][4] = bf_lo(q.z); h[k][5] = bf_hi(q.z); h[k][6] = bf_lo(q.w); h[k][7] = bf_hi(q.w); }
        }
#pragma unroll 1
        for (int hb = 0; hb < CH; hb += 16) {
            v4u qq[16];
#pragma unroll
            for (int r = 0; r < 16; ++r) qq[r] = *(const v4u*)(U + (size_t)(row0 + hb + r) * DR + c0);
#pragma unroll
            for (int r = 0; r < 16; ++r) { const v4u q = qq[r];
                const f32x2 x2[4] = {(f32x2){bf_lo(q.x), bf_hi(q.x)}, (f32x2){bf_lo(q.y), bf_hi(q.y)}, (f32x2){bf_lo(q.z), bf_hi(q.z)}, (f32x2){bf_lo(q.w), bf_hi(q.w)}}; f32x2 o2[4];
#pragma unroll
                for (int p = 0; p < 4; ++p) { const f32x2 w0 = {w[0][2 * p], w[0][2 * p + 1]}, w1 = {w[1][2 * p], w[1][2 * p + 1]}, w2 = {w[2][2 * p], w[2][2 * p + 1]}, w3 = {w[3][2 * p], w[3][2 * p + 1]};
                    const f32x2 h0 = {h[0][2 * p], h[0][2 * p + 1]}, h1 = {h[1][2 * p], h[1][2 * p + 1]}, h2 = {h[2][2 * p], h[2][2 * p + 1]};
                    o2[p] = (f32x2){bb[2 * p], bb[2 * p + 1]} + w0 * h0 + w1 * h1 + w2 * h2 + w3 * x2[p];
                    h[0][2 * p] = h1.x; h[0][2 * p + 1] = h1.y; h[1][2 * p] = h2.x; h[1][2 * p + 1] = h2.y; h[2][2 * p] = x2[p].x; h[2][2 * p + 1] = x2[p].y; }
                v4u ow; ow.x = cvt_pk_bf16(o2[0].x, o2[0].y); ow.y = cvt_pk_bf16(o2[1].x, o2[1].y); ow.z = cvt_pk_bf16(o2[2].x, o2[2].y); ow.w = cvt_pk_bf16(o2[3].x, o2[3].y);
                *(v4u*)(UC + (size_t)(row0 + hb + r) * DR + c0) = ow; }
        }
        if (t0 + CH == slen) {
            float* dst = prompt ? (F.out + O_CONVP + (size_t)(row0 / SP) * 3 * DR) : (F.out + O_CONVS + (size_t)((row0 - TP) / SS) * 3 * DR);
#pragma unroll
            for (int k = 0; k < 3; ++k) { *(f32x4*)(dst + (size_t)k * DR + c0) = (f32x4){h[k][0], h[k][1], h[k][2], h[k][3]}; *(f32x4*)(dst + (size_t)k * DR + c0 + 4) = (f32x4){h[k][4], h[k][5], h[k][6], h[k][7]}; }
        }
    }
}

#define SC_UNPK(v, j) (((j) & 1) ? bf_hi(((j) >> 1) == 0 ? (v).x : ((j) >> 1) == 1 ? (v).y : ((j) >> 1) == 2 ? (v).z : (v).w) : bf_lo(((j) >> 1) == 0 ? (v).x : ((j) >> 1) == 1 ? (v).y : ((j) >> 1) == 2 ? (v).z : (v).w))
#define SC_LOAD(base) do { _Pragma("unroll") for (int r = 0; r < 8; ++r) { la[r] = *(const v4u*)(LA + (base) + (size_t)r * DR); xi[r] = *(const v4u*)(INP + (base) + (size_t)r * DR); gg[r] = *(const v4u*)(GG + (base) + (size_t)r * DR); } } while (0)
#define SC_COMP(v, p) ((p) == 0 ? (v).x : (p) == 1 ? (v).y : (p) == 2 ? (v).z : (v).w)
#define SC_PAIR(v, p) ((f32x2){bf_lo(SC_COMP(v, p)), bf_hi(SC_COMP(v, p))})
#define SC_SWEEP1() do { f32x2 A2_[4], H2_[4]; _Pragma("unroll") for (int p = 0; p < 4; ++p) { A2_[p] = (f32x2){1.f, 1.f}; H2_[p] = (f32x2){0.f, 0.f}; } \
        _Pragma("unroll") for (int r = 0; r < 8; ++r) _Pragma("unroll") for (int p = 0; p < 4; ++p) { const f32x2 a = exp2_pk2(SC_PAIR(la[r], p) * L2E); H2_[p] = a * H2_[p] + SC_PAIR(xi[r], p); A2_[p] = A2_[p] * a; } \
        _Pragma("unroll") for (int p = 0; p < 4; ++p) { Ai[2 * p] = A2_[p].x; Ai[2 * p + 1] = A2_[p].y; Hi[2 * p] = H2_[p].x; Hi[2 * p + 1] = H2_[p].y; } \
        _Pragma("unroll") for (int d = 1; d < 8; d <<= 1) _Pragma("unroll") for (int j = 0; j < 8; ++j) { const float pa = __shfl_up(Ai[j], 8 * d), ph = __shfl_up(Hi[j], 8 * d); if (s >= d) { Hi[j] = Ai[j] * ph + Hi[j]; Ai[j] = Ai[j] * pa; } } \
        _Pragma("unroll") for (int j = 0; j < 8; ++j) { const float pa = __shfl_up(Ai[j], 8), ph = __shfl_up(Hi[j], 8); Ae[j] = s ? pa : 1.f; He[j] = s ? ph : 0.f; } } while (0)
#define SC_SWEEP2(base) do { f32x2 h2_[4]; _Pragma("unroll") for (int p = 0; p < 4; ++p) h2_[p] = (f32x2){Ae[2 * p], Ae[2 * p + 1]} * (f32x2){mine[2 * p], mine[2 * p + 1]} + (f32x2){He[2 * p], He[2 * p + 1]}; \
        _Pragma("unroll") for (int r = 0; r < 8; ++r) { f32x2 o_[4]; \
            _Pragma("unroll") for (int p = 0; p < 4; ++p) { const f32x2 a = exp2_pk2(SC_PAIR(la[r], p) * L2E); h2_[p] = a * h2_[p] + SC_PAIR(xi[r], p); o_[p] = h2_[p] * SC_PAIR(gg[r], p); } \
            v4u w_; w_.x = cvt_pk_bf16(o_[0].x, o_[0].y); w_.y = cvt_pk_bf16(o_[1].x, o_[1].y); w_.z = cvt_pk_bf16(o_[2].x, o_[2].y); w_.w = cvt_pk_bf16(o_[3].x, o_[3].y); \
            *(v4u*)(GG + (base) + (size_t)r * DR) = w_; } \
        _Pragma("unroll") for (int p = 0; p < 4; ++p) { h[2 * p] = h2_[p].x; h[2 * p + 1] = h2_[p].y; } } while (0)
__device__ __forceinline__ f32x2 exp2_pk2(f32x2 t) { f32x2 e; e.x = __builtin_amdgcn_exp2f(t.x); e.y = __builtin_amdgcn_exp2f(t.y); return e; }
__device__ __forceinline__ void scan_phase(const Args& args, Frame& F) {
    const bf16* LA = (const bf16*)(F.ws + WS_LA); const bf16* INP = (const bf16*)(F.ws + WS_INP); bf16* GG = (bf16*)(F.ws + WS_GG);
    LAS float* sT = (LAS float*)(F.lds + RING_OFF);
    constexpr float L2E = 1.4426950408889634f;
    const int lane = lane_id_v(), s = lane >> 3, o = lane & 7, wave = F.wave;
    constexpr int NPU = BP * (DR / 64), NSU = (BS * (DR / 64)) / 8;
    for (int unit = blockIdx.x; unit < NPU + NSU; unit += F.G) {
        v4u la[8], xi[8], gg[8]; float Ai[8], Hi[8], Ae[8], He[8], mine[8], h[8];
        if (unit < NPU) {
            const int b = unit / (DR / 64), cg = unit % (DR / 64), c0 = cg * 64 + o * 8;
            float blk[8];
#pragma unroll
            for (int j = 0; j < 8; ++j) blk[j] = 0.f;
            for (int it = 0; it < 8; ++it) {
                const size_t base = ((size_t)b * SP + (size_t)(it * 512 + wave * 64 + s * 8)) * DR + c0;
                SC_LOAD(base);
                SC_SWEEP1();
                LAS float* st = sT + (it & 1) * (8 * 64 * 2);
                if (s == 7) {
#pragma unroll
                    for (int j = 0; j < 8; ++j) { st[(wave * 64 + o * 8 + j) * 2] = Ai[j]; st[(wave * 64 + o * 8 + j) * 2 + 1] = Hi[j]; } }
                __syncthreads();
#pragma unroll
                for (int w = 0; w < 8; ++w) {
#pragma unroll
                    for (int j = 0; j < 8; ++j) { const float aw = st[(w * 64 + o * 8 + j) * 2], hw = st[(w * 64 + o * 8 + j) * 2 + 1]; if (w == wave) mine[j] = blk[j]; blk[j] = aw * blk[j] + hw; } }
                SC_SWEEP2(base);
            }
            if (wave == 7 && s == 7) { float* dst = F.out + O_HP + (size_t)b * DR + c0; *(f32x4*)dst = (f32x4){h[0], h[1], h[2], h[3]}; *(f32x4*)(dst + 4) = (f32x4){h[4], h[5], h[6], h[7]}; }
            __syncthreads();
        } else {
            const int su = (unit - NPU) * 8 + wave, b = su / (DR / 64), cg = su % (DR / 64), c0 = cg * 64 + o * 8;
            const size_t base = ((size_t)TP + (size_t)(b * SS + s * 8)) * DR + c0;
            SC_LOAD(base);
            { const float* h0 = IN_(3) + (size_t)b * DR + c0; const f32x4 a = *(const f32x4*)h0, c = *(const f32x4*)(h0 + 4);
              mine[0] = a[0]; mine[1] = a[1]; mine[2] = a[2]; mine[3] = a[3]; mine[4] = c[0]; mine[5] = c[1]; mine[6] = c[2]; mine[7] = c[3]; }
            SC_SWEEP1();
            SC_SWEEP2(base);
            if (s == 7) { float* dst = F.out + O_HS + (size_t)b * DR + c0; *(f32x4*)dst = (f32x4){h[0], h[1], h[2], h[3]}; *(f32x4*)(dst + 4) = (f32x4){h[4], h[5], h[6], h[7]}; }
        }
    }
}
#undef SC_UNPK
#undef SC_COMP
#undef SC_PAIR
#undef SC_LOAD
#undef SC_SWEEP1
#undef SC_SWEEP2

__device__ __forceinline__ void knorm_items(Frame& F) {
    const int lane = lane_id_v(), tid = F.wave * 64 + lane;
    LAS unsigned* mx = (LAS unsigned*)(F.lds + RING_OFF);
    for (int it = F.G - 1 - (int)blockIdx.x; it < BP * 64; it += F.G) {
        const int b = it >> 6, Tt = it & 63;
        __syncthreads();
        if (tid < 16) mx[tid] = 0u;
        __syncthreads();
        const bf16* Kp = (const bf16*)(F.ws + WS_KP) + ((size_t)b * SP + (size_t)Tt * 64) * DM + (tid & 255) * 8;
        float rmax = 0.f;
#pragma unroll 1
        for (int p0 = 0; p0 < 32; p0 += 16) {
            v4u v[16];
#pragma unroll
            for (int i = 0; i < 16; ++i) v[i] = *(const v4u*)(Kp + (size_t)((p0 + i) * 2 + (tid >> 8)) * DM);
#pragma unroll
            for (int i = 0; i < 16; ++i) { const v4u w = v[i];
                float s_ = bf_lo(w.x) * bf_lo(w.x) + bf_hi(w.x) * bf_hi(w.x) + bf_lo(w.y) * bf_lo(w.y) + bf_hi(w.y) * bf_hi(w.y) + bf_lo(w.z) * bf_lo(w.z) + bf_hi(w.z) * bf_hi(w.z) + bf_lo(w.w) * bf_lo(w.w) + bf_hi(w.w) * bf_hi(w.w);
                s_ += __shfl_xor(s_, 1); s_ += __shfl_xor(s_, 2); s_ += __shfl_xor(s_, 4); s_ += __shfl_xor(s_, 8);
                rmax = fmaxf(rmax, s_); }
        }
        if ((lane & 15) == 0) atomicMax((unsigned*)(mx + ((tid & 255) >> 4)), __float_as_uint(rmax));
        __syncthreads();
        if (tid < 16) ((float*)(F.ws + WS_KMX))[((size_t)b * NH + tid) * 64 + Tt] = __builtin_sqrtf(__uint_as_float(mx[tid]));
    }
    __syncthreads();
}
__device__ __forceinline__ void cumsum_items(const Args& args, Frame& F) {
    const int item = (F.G - 1 - (int)blockIdx.x) * NWAVES + F.wave;
    const int lane = lane_id_v();
    for (int it = item; it < BP * NH + BS * NH; it += F.G * NWAVES) {
        if (it < BP * NH) { const int b = it / NH, h = it % NH; const float* lf = F.out + O_LFP + ((size_t)b * SP + (size_t)lane * 64) * NH + h;
            float s = 0.f;
            for (int t = 0; t < 64; ++t) s += lf[(size_t)t * NH];
            float incl = s;
#pragma unroll
            for (int o = 1; o < 64; o <<= 1) { const float v = __shfl_up(incl, o); if (lane >= o) incl += v; }
            float run = incl - s; float* dst = (float*)(F.ws + WS_CP) + ((size_t)b * NH + h) * SP + lane * 64;
            for (int t = 0; t < 64; ++t) { run += lf[(size_t)t * NH]; dst[t] = -run * INV_ATT_SCALE; }
        } else { const int r = it - BP * NH, b = r / NH, h = r % NH; const float* cl = IN_(6) + (size_t)b * PAST * NH + h; const float* lf = F.out + O_LFS + (size_t)b * SS * NH + h;
            float s = 0.f;
            for (int t = 0; t < 17; ++t) { const int p = lane * 17 + t; s += (p < PAST) ? cl[(size_t)p * NH] : lf[(size_t)(p - PAST) * NH]; }
            float incl = s;
#pragma unroll
            for (int o = 1; o < 64; o <<= 1) { const float v = __shfl_up(incl, o); if (lane >= o) incl += v; }
            float run = incl - s; float* dst = (float*)(F.ws + WS_CS) + ((size_t)b * NH + h) * SKS + lane * 17;
            for (int t = 0; t < 17; ++t) { const int p = lane * 17 + t; run += (p < PAST) ? cl[(size_t)p * NH] : lf[(size_t)(p - PAST) * NH]; dst[t] = -run * INV_ATT_SCALE; }
        }
    }
}

__device__ __forceinline__ void final_norm(const Args& args, Frame& F) {
    const bf16* XB = (const bf16*)(F.ws + WS_XB); const float* ssq = (const float*)(F.ws + SSQ_OFF) + (size_t)6 * T; const float* gn = IN_(25);
    const int gw = F.vcu * NWAVES + F.wave, NGW = F.G * NWAVES, lane = lane_id_v();
    f32x4 gv[8];
#pragma unroll
    for (int j = 0; j < 4; ++j) { gv[2 * j] = *(const f32x4*)(gn + 8 * lane + 512 * j); gv[2 * j + 1] = *(const f32x4*)(gn + 8 * lane + 512 * j + 4); }
    for (int m = gw; m < T; m += NGW) { const float s = __builtin_amdgcn_rsqf(ssq[m] * (1.0f / DM) + RMS_EPS);
        const bf16* xr = XB + (size_t)m * DM + 8 * lane; float* yr = F.out + O_YP + (size_t)m * DM + 8 * lane;
        v4u q[4];
#pragma unroll
        for (int j = 0; j < 4; ++j) q[j] = *(const v4u*)(xr + 512 * j);
#pragma unroll
        for (int j = 0; j < 4; ++j) { const f32x4 a = {bf_lo(q[j].x), bf_hi(q[j].x), bf_lo(q[j].y), bf_hi(q[j].y)}, b = {bf_lo(q[j].z), bf_hi(q[j].z), bf_lo(q[j].w), bf_hi(q[j].w)};
            __builtin_nontemporal_store(a * s * gv[2 * j], (f32x4*)(yr + 512 * j)); __builtin_nontemporal_store(b * s * gv[2 * j + 1], (f32x4*)(yr + 512 * j + 4)); } }
}

__device__ __forceinline__ void splitk_reduce(Frame& F, const float* xin_s, float* ssq, float coef, int first) {
    const float* slab = (const float*)(F.ws + WS_INP); bf16* XB = (bf16*)(F.ws + WS_XB) + (size_t)TP * DM;
    const int lane = lane_id_v(), t = F.wave * 64 + lane;
    for (int rb = blockIdx.x; rb < TS / 4; rb += F.G) {
        const int row = rb * 4 + (t >> 7), col = (t & 127) * 16, pm = row >> 8, pn = col >> 8;
        const bf16* sl = (const bf16*)slab + ((size_t)((pm * 8 + pn) * 8) << 16) + (size_t)(row & 255) * 256 + (col & 255);
        v4u sw[8][2];
#pragma unroll
        for (int sp = 0; sp < 8; ++sp) { sw[sp][0] = *(const v4u*)(sl + ((size_t)sp << 16)); sw[sp][1] = *(const v4u*)(sl + ((size_t)sp << 16) + 8); }
        f32x4 a[4];
#pragma unroll
        for (int j = 0; j < 4; ++j) a[j] = (f32x4){0.f, 0.f, 0.f, 0.f};
#pragma unroll
        for (int sp = 0; sp < 8; ++sp)
#pragma unroll
            for (int hh = 0; hh < 2; ++hh) { const v4u w = sw[sp][hh];
                a[2 * hh] += (f32x4){bf_lo(w.x), bf_hi(w.x), bf_lo(w.y), bf_hi(w.y)}; a[2 * hh + 1] += (f32x4){bf_lo(w.z), bf_hi(w.z), bf_lo(w.w), bf_hi(w.w)}; }
        const size_t off = (size_t)row * DM + col; f32x4 xo[4];
        if (first) {
#pragma unroll
            for (int j = 0; j < 4; ++j) xo[j] = *(const f32x4*)(xin_s + off + 4 * j); }
        else { const v4u w0 = *(const v4u*)(XB + off), w1 = *(const v4u*)(XB + off + 8);
            xo[0] = (f32x4){bf_lo(w0.x), bf_hi(w0.x), bf_lo(w0.y), bf_hi(w0.y)}; xo[1] = (f32x4){bf_lo(w0.z), bf_hi(w0.z), bf_lo(w0.w), bf_hi(w0.w)};
            xo[2] = (f32x4){bf_lo(w1.x), bf_hi(w1.x), bf_lo(w1.y), bf_hi(w1.y)}; xo[3] = (f32x4){bf_lo(w1.z), bf_hi(w1.z), bf_lo(w1.w), bf_hi(w1.w)}; }
        float q = 0.f; unsigned pk[8];
#pragma unroll
        for (int j = 0; j < 4; ++j) { const f32x4 xn = xo[j] + a[j] * coef; q += (xn[0] * xn[0] + xn[1] * xn[1]) + (xn[2] * xn[2] + xn[3] * xn[3]);
            pk[2 * j] = cvt_pk_bf16(xn[0], xn[1]); pk[2 * j + 1] = cvt_pk_bf16(xn[2], xn[3]); }
        *(v4u*)(XB + off) = (v4u){pk[0], pk[1], pk[2], pk[3]}; *(v4u*)(XB + off + 8) = (v4u){pk[4], pk[5], pk[6], pk[7]};
        q = wave_sum(q);
        if (lane == 0) __hip_atomic_fetch_add(ssq + TP + row, q, __ATOMIC_RELAXED, __HIP_MEMORY_SCOPE_AGENT);
    }
}

__device__ __forceinline__ fox::BlockRef att_ref(int item, int pass) {
    fox::BlockRef r;
    if (item < BP * NH * 8) { const int bh = item >> 3, x = (item & 7) ^ ((item & 256) ? 7 : 0), qb = pass ? 15 - x : x, b = bh >> 4, h = bh & 15;
        r.qo = (unsigned)((b * SP + qb * 256) * DM + h * HD); r.ko = (unsigned)(b * SP * DM + h * HD); r.co = (unsigned)((b * NH + h) * SP); r.P0 = qb * 256; r.smp = 0; }
    else { r.qo = 0; r.ko = 0; r.co = 0; r.P0 = 0; r.smp = 0; }
    return r;
}
__device__ __forceinline__ void attn_phase(const Args& args, Frame& F, char* lds) {
    constexpr int NPI = BP * NH * 8;
    const int lane = lane_id_v();
    int item = F.vcu;
    if (item < NPI) {
        int pass = 0; fox::BlockRef cur = att_ref(item, 0);
        fox::Seam S; int stg = 0;
        PG8_LAS unsigned char* l3 = (PG8_LAS unsigned char*)F.lds + RING_OFF;
        fox::fox_prime(F.ws, cur, lds, l3, S, F.wave);
        for (;;) {
            const bool more_pass = (pass == 0), more_item = item + F.G < NPI, last = !more_pass && !more_item;
            int itn = item, passn = pass + 1;
            if (!more_pass) { passn = 0; itn = more_item ? item + F.G : item; }
            const fox::BlockRef nxt = last ? cur : att_ref(itn, passn);
            fox::fox_block(F.ws, cur, nxt, lds, l3, S, stg, F.wave, lane);
            if (last) break;
            cur = nxt; item = itn; pass = passn;
        }
        asm volatile("s_waitcnt vmcnt(0)" ::: "memory");
    }
    for (int s = F.vcu; s < BS * NH; s += F.G) { __syncthreads(); fox::fox_sample(F.ws, IN_(4), IN_(5), s >> 4, s & 15, lds, F.wave, lane); __syncthreads(); }
}

constexpr int NPHASES = 18;
__global__ void __launch_bounds__(NWAVES * 64, 2) fwd(Args args) {
    extern __shared__ __attribute__((aligned(16))) unsigned char lds[];
    Frame F;
    F.lds = (LAS unsigned char*)lds; F.MISC = (volatile LAS unsigned*)(F.lds + MISC_OFF);
    F.wave = __builtin_amdgcn_readfirstlane((int)threadIdx.x >> 6);
    F.G = gridDim.x; { const int bx = blockIdx.x; F.vcu = (F.G % 8 == 0) ? (bx % 8) * (F.G / 8) + bx / 8 : bx; }
    F.ws = args.ws; F.out = args.out;
    unsigned char* ws = args.ws;
    for (int u = threadIdx.x; u < (LDS_BYTES - LDSCTL_OFF) / 4; u += NWAVES * 64) ((LAS unsigned*)(F.lds + LDSCTL_OFF))[u] = 0u;
    __syncthreads();
#if MK_PER_PHASE
#define GRID_BAR() do { } while (0)
#else
    XcdBarrier bar = xcd_barrier_post((unsigned*)(ws + WS_CTL) + CW_BAR, F.MISC + 8);
#define GRID_BAR() xcd_barrier(bar)
#endif
    const int lo = args.ph_lo, hi = args.ph_hi;
#define PROBE_BEGIN(k) const unsigned long long _pt0 = ((PROBE_MASK >> (k)) & 1) ? __builtin_amdgcn_s_memrealtime() : 0ull
#define PROBE_END(k) do { if ((PROBE_MASK >> (k)) & 1) { const unsigned long long _pt1 = __builtin_amdgcn_s_memrealtime(); while (__builtin_amdgcn_s_memrealtime() - _pt1 < _pt1 - _pt0) __builtin_amdgcn_s_sleep(32); } } while (0)
#ifndef PH_MASK
#define PH_MASK 0x3ffff
#endif
#define IN(k) (((PH_MASK >> (k)) & 1) && lo <= (k) && (k) < hi)
#define BOTH(k) (IN(k) && IN((k) + 1))
    float* ssq = (float*)(ws + SSQ_OFF);
    bf16* XB = (bf16*)(ws + WS_XB); bf16* Hb = (bf16*)(ws + WS_H);
    LAS unsigned char* ring = F.lds + RING_OFF;
    const int bx = (int)blockIdx.x;

#define FFN_G1(f, ssin) do { pg8::Gemm g{XB, (const bf16*)(ws + WS_W1 + (size_t)(f) * SZ_W1), T, 2 * DFF, DM, DM}; pg8::StaticOrder S; S.init(T, 2 * DFF, DM, F.G, bx); \
        pg8::EpiSwiGLU E{Hb, ssq + (size_t)(ssin) * T}; pg8::gemm_phase<pg8::EpiSwiGLU, pg8::StaticOrder>(ring, g, S, E, F.wave); } while (0)
#define RES_GEMM(Aptr, Wptr, Kdim, ssout, cf, fst) do { pg8::Gemm g{(const bf16*)(Aptr), (const bf16*)(Wptr), T, DM, (Kdim), (Kdim)}; pg8::ResOrder S; S.init((Kdim), F.G, bx); \
        pg8::EpiRes E{args.in[0], args.in[1], XB, ssq + (size_t)(ssout) * T, (cf), (float*)(ws + WS_INP), (fst)}; pg8::gemm_phase<pg8::EpiRes, pg8::ResOrder>(ring, g, S, E, F.wave); \
        GRID_BAR(); splitk_reduce(F, args.in[1], ssq + (size_t)(ssout) * T, (cf), (fst)); } while (0)

    if (IN(0)) { PROBE_BEGIN(0); p0_prologue(args, F); if (BOTH(0)) GRID_BAR(); PROBE_END(0); }
    if (IN(1)) { PROBE_BEGIN(1); FFN_G1(0, 0); convert_tiles(args, F, TT_E0, TT_E0 + TT_W2, 176); if (BOTH(1)) GRID_BAR(); PROBE_END(1); }
    if (IN(2)) { PROBE_BEGIN(2); RES_GEMM(Hb, ws + WS_W2, DFF, 1, 0.5f, 0); convert_tiles(args, F, TT_E1, TT_E2); if (BOTH(2)) GRID_BAR(); PROBE_END(2); }
    if (IN(3)) { PROBE_BEGIN(3); pg8::Gemm g{XB, (const bf16*)(ws + WS_WAIN), T, 2 * DR, DM, DM}; pg8::StaticOrder S; S.init(T, 2 * DR, DM, F.G, bx);
        pg8::EpiAin E{(bf16*)(ws + WS_GG), (bf16*)(ws + WS_U), ssq + (size_t)1 * T}; pg8::gemm_phase<pg8::EpiAin, pg8::StaticOrder>(ring, g, S, E, F.wave); convert_tiles(args, F, TT_E2, TT_E4, 80); convert_tiles(args, F, TT_W1, 2 * TT_W1, 80); if (BOTH(3)) GRID_BAR(); PROBE_END(3); }
    if (IN(4)) { PROBE_BEGIN(4); conv_phase(args, F); if (BOTH(4)) GRID_BAR(); PROBE_END(4); }
    if (IN(5)) { PROBE_BEGIN(5); pg8::Gemm g{(const bf16*)(ws + WS_UC), (const bf16*)(ws + WS_WG), T, 2 * DR, 256, DR}; pg8::StaticOrder S; S.init(T, 2 * DR, 256, F.G, bx);
        pg8::EpiGates E{(const bf16*)(ws + WS_UC), (bf16*)(ws + WS_LA), (bf16*)(ws + WS_INP), args.in[15], (const float*)(ws + WS_CL)}; pg8::gemm_phase<pg8::EpiGates, pg8::StaticOrder>(ring, g, S, E, F.wave); convert_tiles(args, F, TT_E0 + TT_W2, TT_E0 + 2 * TT_W2, 80); if (BOTH(5)) GRID_BAR(); PROBE_END(5); }
    if (IN(6)) { PROBE_BEGIN(6); scan_phase(args, F); if (BOTH(6)) GRID_BAR(); PROBE_END(6); }
    if (IN(7)) { PROBE_BEGIN(7); RES_GEMM(ws + WS_GG, ws + WS_WAOUT, DR, 2, 1.0f, 0); if (BOTH(7)) GRID_BAR(); PROBE_END(7); }
    if (IN(8)) { PROBE_BEGIN(8); FFN_G1(1, 2); convert_tiles(args, F, TT_E4, TT_E5, 176); if (BOTH(8)) GRID_BAR(); PROBE_END(8); }
    if (IN(9)) { PROBE_BEGIN(9); RES_GEMM(Hb, ws + WS_W2 + SZ_W2, DFF, 3, 0.5f, 0); convert_tiles(args, F, 2 * TT_W1, 3 * TT_W1); if (BOTH(9)) GRID_BAR(); PROBE_END(9); }
    if (IN(10)) { PROBE_BEGIN(10);
        { pg8::Gemm g{XB, (const bf16*)(ws + WS_WKV), T, 2 * DM + 256, DM, DM}; pg8::StaticOrder S; S.init(T, 2 * DM + 256, DM, F.G, bx);
          pg8::EpiKV E{F.out, ws, ssq + (size_t)3 * T, args.in[21]};
          pg8::gemm_phase<pg8::EpiKV, pg8::StaticOrder>(ring, g, S, E, F.wave); }
        FFN_G1(2, 3);
        convert_tiles(args, F, TT_E0 + 2 * TT_W2, TT_E0 + 3 * TT_W2, 176); convert_tiles(args, F, TT_E5, TT_E6, 176); if (BOTH(10)) GRID_BAR(); PROBE_END(10); }
    if (IN(11)) { PROBE_BEGIN(11); RES_GEMM(Hb, ws + WS_W2 + 2 * SZ_W2, DFF, 4, 0.5f, 0); knorm_items(F); if (BOTH(11)) GRID_BAR(); PROBE_END(11); }
    if (IN(12)) { PROBE_BEGIN(12); pg8::Gemm g{XB, (const bf16*)(ws + WS_WQG), T, 2 * DM, DM, DM}; pg8::StaticOrder S; S.init(T, 2 * DM, DM, F.G, bx);
        pg8::EpiQG E{(bf16*)(ws + WS_Q), (bf16*)(ws + WS_SG), ssq + (size_t)4 * T}; pg8::gemm_phase<pg8::EpiQG, pg8::StaticOrder>(ring, g, S, E, F.wave); cumsum_items(args, F);   convert_tiles(args, F, TT_E6, TT_TOTAL, 64); convert_tiles(args, F, 3 * TT_W1, 4 * TT_W1, 64); if (BOTH(12)) GRID_BAR(); PROBE_END(12); }
    if (IN(13)) { PROBE_BEGIN(13); attn_phase(args, F, (char*)lds + RING_OFF); if (BOTH(13)) GRID_BAR(); PROBE_END(13); }
    if (IN(14)) { PROBE_BEGIN(14); RES_GEMM(ws + WS_Q, ws + WS_WO, DM, 5, 1.0f, 0); if (BOTH(14)) GRID_BAR(); PROBE_END(14); }
    if (IN(15)) { PROBE_BEGIN(15); FFN_G1(3, 5); convert_tiles(args, F, TT_E0 + 3 * TT_W2, TT_E0 + 4 * TT_W2, 176); if (BOTH(15)) GRID_BAR(); PROBE_END(15); }
    if (IN(16)) { PROBE_BEGIN(16); RES_GEMM(Hb, ws + WS_W2 + 3 * SZ_W2, DFF, 6, 0.5f, 0); if (BOTH(16)) GRID_BAR(); PROBE_END(16); }
    if (IN(17)) { PROBE_BEGIN(17); final_norm(args, F); PROBE_END(17); }
#undef IN
#undef BOTH
}

extern "C" void kernel_launch(void* const* d_in, const int* in_sizes, int n_in, void* d_out, int out_size, void* d_ws, size_t ws_size, hipStream_t stream) {
    static int grid = 0;
    if (grid == 0) {
        if (n_in != 26 || in_sizes[0] != TP * DM || (size_t)out_size != O_END || ws_size < WS_END) {
            fprintf(stderr, "kernel_launch: shape mismatch (n_in %d, in0 %d, out %d (want %zu), ws %zu (want %zu)); nothing launched\n", n_in, n_in > 0 ? in_sizes[0] : -1, out_size, (size_t)O_END, ws_size, (size_t)WS_END); grid = -1; return; }
        int dev = 0, cus = 0, per_cu = 0;
        if (hipGetDevice(&dev) != hipSuccess || hipDeviceGetAttribute(&cus, hipDeviceAttributeMultiprocessorCount, dev) != hipSuccess) { fprintf(stderr, "kernel_launch: device query failed\n"); grid = -1; return; }
        if (hipFuncSetAttribute((const void*)fwd, hipFuncAttributeMaxDynamicSharedMemorySize, LDS_BYTES) != hipSuccess) { fprintf(stderr, "kernel_launch: hipFuncSetAttribute failed\n"); grid = -1; return; }
        if (hipOccupancyMaxActiveBlocksPerMultiprocessor(&per_cu, (const void*)fwd, NWAVES * 64, LDS_BYTES) != hipSuccess || per_cu < 1)
            fprintf(stderr, "kernel_launch: note: occupancy query reports %d workgroups per CU\n", per_cu);
        (void)hipGetLastError();
        grid = cus;
    }
    if (grid < 0) return;
    if (hipMemsetAsync((char*)d_ws + WS_CTL, 0, CTL_ZERO_BYTES, stream) != hipSuccess) { fprintf(stderr, "kernel_launch: memset failed\n"); return; }
    Args a{};
    for (int i = 0; i < 26; ++i) a.in[i] = (const float*)d_in[i];
    a.out = (float*)d_out; a.ws = (unsigned char*)d_ws;
#if MK_PER_PHASE
    for (int p = 0; p < NPHASES; ++p) { a.ph_lo = p; a.ph_hi = p + 1; hipLaunchKernelGGL(fwd, dim3(grid), dim3(NWAVES * 64), LDS_BYTES, stream, a); }
#else
    a.ph_lo = 0; a.ph_hi = NPHASES;
    hipLaunchKernelGGL(fwd, dim3(grid), dim3(NWAVES * 64), LDS_BYTES, stream, a);
#endif
    const hipError_t le = hipPeekAtLastError();
    if (le != hipSuccess) fprintf(stderr, "kernel_launch: launch failed: %s\n", hipGetErrorName(le));
}
```
